# Optimizing an MI355X kernel written in HIP

```python
import math
import jax, jax.numpy as jnp
from jax import lax
import numpy as np

D_MODEL = 2048
BATCH = 8
SEQ = 2048
DEPTH = 1
DEC_BATCH = 1
DEC_SEQ = 8192
PAST_LEN = 128

NORM_EPS = 1e-6
D_FF = 5632
RG_WIDTH = 1024
RG_BLOCKS = 16
RG_BLOCK_W = RG_WIDTH // RG_BLOCKS
RG_C = 8.0
CONV_W = 4
CONV_PAD_L = 2
CONV_PAD_R = 1
MLA_HEADS = 8
Q_LORA = 512
KV_LORA = 256
QK_NOPE = 128
QK_ROPE = 64
V_DIM = 128
MLA_WIDTH = MLA_HEADS * V_DIM
ROPE_THETA = 10000.0
Q_BLOCK = 128
IN_SPLITS = (RG_WIDTH, 2 * RG_WIDTH, 2 * RG_WIDTH + Q_LORA, 2 * RG_WIDTH + Q_LORA + KV_LORA)
D_IN = 2 * RG_WIDTH + Q_LORA + KV_LORA + QK_ROPE
D_MIX = RG_WIDTH + MLA_WIDTH

kernel_name = "hymba_rglru_mla_macaron_encoder"


def rms_norm(x, g):
    xf = x.astype(jnp.float32)
    y = xf * lax.rsqrt(jnp.mean(xf * xf, axis=-1, keepdims=True) + NORM_EPS)
    return (y * g.astype(jnp.float32)).astype(x.dtype)


def swiglu(x, w_gate, w_up, w_down):
    return (jax.nn.silu(x @ w_gate) * (x @ w_up)) @ w_down


def centred_depthwise_conv(x, w, b):
    c = x.shape[-1]
    y = lax.conv_general_dilated(
        x, w[:, None, :].astype(x.dtype), window_strides=(1,),
        padding=[(CONV_PAD_L, CONV_PAD_R)],
        dimension_numbers=("NWC", "WIO", "NWC"), feature_group_count=c)
    return y + b


def _linear_rec_combine(left, right):
    a1, b1 = left
    a2, b2 = right
    return a1 * a2, a2 * b1 + b2


def rg_lru_direction(xc, w_a, b_a, w_x, b_x, lam, reverse):
    bsz, s, c = xc.shape
    xb = xc.reshape(bsz, s, RG_BLOCKS, RG_BLOCK_W)
    r = jax.nn.sigmoid(jnp.einsum("bshi,hij->bshj", xb, w_a) + b_a).reshape(bsz, s, c)
    i = jax.nn.sigmoid(jnp.einsum("bshi,hij->bshj", xb, w_x) + b_x).reshape(bsz, s, c)
    log_a = -RG_C * r.astype(jnp.float32) * jax.nn.softplus(-lam.astype(jnp.float32))
    a = jnp.exp(log_a)
    mult = jnp.sqrt(-jnp.expm1(2.0 * log_a))
    bterm = mult * (i * xc).astype(jnp.float32)
    _, h = lax.associative_scan(_linear_rec_combine, (a, bterm), axis=1, reverse=reverse)
    return h


def rope_tables(seq):
    inv = 1.0 / (ROPE_THETA ** (jnp.arange(0, QK_ROPE, 2, dtype=jnp.float32) / QK_ROPE))
    ang = jnp.arange(seq, dtype=jnp.float32)[:, None] * inv[None, :]
    return jnp.cos(ang), jnp.sin(ang)


def apply_rope(x, cos, sin):
    xf = x.astype(jnp.float32)
    x1, x2 = jnp.split(xf, 2, axis=-1)
    out = jnp.concatenate([x1 * cos - x2 * sin, x2 * cos + x1 * sin], axis=-1)
    return out.astype(x.dtype)


def mla_attention(qn, qr, kn, kr, v):
    bsz, s, h, _ = qn.shape
    nb = s // Q_BLOCK
    scale = 1.0 / math.sqrt(QK_NOPE + QK_ROPE)

    def block(args):
        qn_b, qr_b = args
        sc = (jnp.einsum("bqhd,bkhd->bhqk", qn_b, kn, preferred_element_type=jnp.float32)
              + jnp.einsum("bqhr,bkr->bhqk", qr_b, kr, preferred_element_type=jnp.float32))
        p = jax.nn.softmax(sc * scale, axis=-1).astype(v.dtype)
        return jnp.einsum("bhqk,bkhd->bqhd", p, v)

    qn_blk = qn.reshape(bsz, nb, Q_BLOCK, h, QK_NOPE).transpose(1, 0, 2, 3, 4)
    qr_blk = qr.reshape(bsz, nb, Q_BLOCK, h, QK_ROPE).transpose(1, 0, 2, 3, 4)
    out = lax.map(block, (qn_blk, qr_blk))
    return out.transpose(1, 0, 2, 3, 4).reshape(bsz, s, h * V_DIM)


def hybrid_mixer(h, w_in, conv_w, conv_b, rg_w_a, rg_b_a, rg_w_x, rg_b_x, rg_lambda,
                 q_a_norm, w_q_b, kv_a_norm, w_kv_b, rg_out_norm, attn_out_norm, w_out):
    bsz, s, _ = h.shape
    z = h @ w_in
    x_rg, g_rg, q_c, kv_c, k_r = jnp.split(z, IN_SPLITS, axis=-1)
    xc = centred_depthwise_conv(x_rg, conv_w, conv_b)
    h_f = rg_lru_direction(xc, rg_w_a[0], rg_b_a[0], rg_w_x[0], rg_b_x[0], rg_lambda[0], False)
    h_b = rg_lru_direction(xc, rg_w_a[1], rg_b_a[1], rg_w_x[1], rg_b_x[1], rg_lambda[1], True)
    y_rg = ((h_f + h_b) * jax.nn.gelu(g_rg.astype(jnp.float32))).astype(h.dtype)
    q = (rms_norm(q_c, q_a_norm) @ w_q_b).reshape(bsz, s, MLA_HEADS, QK_NOPE + QK_ROPE)
    qn, qr = q[..., :QK_NOPE], q[..., QK_NOPE:]
    kv = (rms_norm(kv_c, kv_a_norm) @ w_kv_b).reshape(bsz, s, MLA_HEADS, QK_NOPE + V_DIM)
    kn, v = kv[..., :QK_NOPE], kv[..., QK_NOPE:]
    cos, sin = rope_tables(s)
    qr = apply_rope(qr, cos[:, None, :], sin[:, None, :])
    kr = apply_rope(k_r, cos, sin)
    y_att = mla_attention(qn, qr, kn, kr, v)
    y = jnp.concatenate([rms_norm(y_rg, rg_out_norm), rms_norm(y_att, attn_out_norm)], axis=-1)
    return y @ w_out


def setup_inputs(seed: int = 0) -> dict:
    key = jax.random.key(seed)
    ks = jax.random.split(key, 32)

    def nrm(k, shape, fan_in):
        return jax.random.normal(k, shape, jnp.float32) * (fan_in ** -0.5)

    def gain(k, shape):
        return 1.0 + 0.01 * jax.random.normal(k, shape, jnp.float32)

    L = DEPTH
    u = jax.random.uniform(ks[13], (L, 2, RG_WIDTH), jnp.float32, minval=0.9, maxval=0.999)
    sig = u ** (1.0 / RG_C)
    rg_lambda = jnp.log(sig / (1.0 - sig))
    return {
        "x_prompt": jax.random.normal(ks[0], (BATCH, SEQ, D_MODEL), jnp.float32),
        "x_sample": jax.random.normal(ks[1], (DEC_BATCH, DEC_SEQ, D_MODEL), jnp.float32),
        "ffn1_norm": gain(ks[2], (L, D_MODEL)),
        "ffn1_w_gate": nrm(ks[3], (L, D_MODEL, D_FF), D_MODEL),
        "ffn1_w_up": nrm(ks[4], (L, D_MODEL, D_FF), D_MODEL),
        "ffn1_w_down": nrm(ks[5], (L, D_FF, D_MODEL), D_FF),
        "mix_norm": gain(ks[6], (L, D_MODEL)),
        "w_in": nrm(ks[7], (L, D_MODEL, D_IN), D_MODEL),
        "conv_w": nrm(ks[8], (L, CONV_W, RG_WIDTH), CONV_W),
        "conv_b": 0.01 * jax.random.normal(ks[9], (L, RG_WIDTH), jnp.float32),
        "rg_w_a": nrm(ks[10], (L, 2, RG_BLOCKS, RG_BLOCK_W, RG_BLOCK_W), RG_BLOCK_W),
        "rg_b_a": 0.01 * jax.random.normal(ks[11], (L, 2, RG_BLOCKS, RG_BLOCK_W), jnp.float32),
        "rg_w_x": nrm(ks[12], (L, 2, RG_BLOCKS, RG_BLOCK_W, RG_BLOCK_W), RG_BLOCK_W),
        "rg_b_x": 0.01 * jax.random.normal(ks[14], (L, 2, RG_BLOCKS, RG_BLOCK_W), jnp.float32),
        "rg_lambda": rg_lambda,
        "q_a_norm": gain(ks[15], (L, Q_LORA)),
        "w_q_b": nrm(ks[16], (L, Q_LORA, MLA_HEADS * (QK_NOPE + QK_ROPE)), Q_LORA),
        "kv_a_norm": gain(ks[17], (L, KV_LORA)),
        "w_kv_b": nrm(ks[18], (L, KV_LORA, MLA_HEADS * (QK_NOPE + V_DIM)), KV_LORA),
        "rg_out_norm": gain(ks[19], (L, RG_WIDTH)),
        "attn_out_norm": gain(ks[20], (L, MLA_WIDTH)),
        "w_out": nrm(ks[21], (L, D_MIX, D_MODEL), D_MIX),
        "ffn2_norm": gain(ks[22], (L, D_MODEL)),
        "ffn2_w_gate": nrm(ks[23], (L, D_MODEL, D_FF), D_MODEL),
        "ffn2_w_up": nrm(ks[24], (L, D_MODEL, D_FF), D_MODEL),
        "ffn2_w_down": nrm(ks[25], (L, D_FF, D_MODEL), D_FF),
        "final_norm": gain(ks[26], (D_MODEL,)),
    }


def reference(x_prompt, x_sample, ffn1_norm, ffn1_w_gate, ffn1_w_up, ffn1_w_down, mix_norm,
              w_in, conv_w, conv_b, rg_w_a, rg_b_a, rg_w_x, rg_b_x, rg_lambda,
              q_a_norm, w_q_b, kv_a_norm, w_kv_b, rg_out_norm, attn_out_norm, w_out,
              ffn2_norm, ffn2_w_gate, ffn2_w_up, ffn2_w_down, final_norm):
    def trunk(x):
        for l in range(DEPTH):
            x = x + 0.5 * swiglu(rms_norm(x, ffn1_norm[l]), ffn1_w_gate[l], ffn1_w_up[l], ffn1_w_down[l])
            x = x + hybrid_mixer(rms_norm(x, mix_norm[l]), w_in[l], conv_w[l], conv_b[l],
                                 rg_w_a[l], rg_b_a[l], rg_w_x[l], rg_b_x[l], rg_lambda[l],
                                 q_a_norm[l], w_q_b[l], kv_a_norm[l], w_kv_b[l],
                                 rg_out_norm[l], attn_out_norm[l], w_out[l])
            x = x + 0.5 * swiglu(rms_norm(x, ffn2_norm[l]), ffn2_w_gate[l], ffn2_w_up[l], ffn2_w_down[l])
        return rms_norm(x, final_norm)

    y_prompt = trunk(x_prompt)
    y_sample = trunk(x_sample)
    return (y_prompt, y_sample)
```

```cpp
#include <hip/hip_runtime.h>
#include <hip/hip_cooperative_groups.h>
#include <cstdio>
#include <cstdint>
namespace cg = cooperative_groups;

#define LAS __attribute__((address_space(3)))
typedef unsigned short bf16_t;
typedef short bf16x8 __attribute__((ext_vector_type(8)));
typedef short s16x4 __attribute__((ext_vector_type(4)));
typedef float f32x2 __attribute__((ext_vector_type(2)));
typedef float f32x4 __attribute__((ext_vector_type(4)));
typedef float f32x16 __attribute__((ext_vector_type(16)));
typedef unsigned u32x2 __attribute__((ext_vector_type(2)));
typedef unsigned u32x4 __attribute__((ext_vector_type(4)));
typedef _Float16 h16x2 __attribute__((ext_vector_type(2)));
typedef _Float16 h16x8 __attribute__((ext_vector_type(8)));
typedef _Float16 h16x4 __attribute__((ext_vector_type(4)));

constexpr int T = 24576, TP = 16384;
constexpr int DM = 2048, FF = 5632, NGU = 2 * FF, RG = 1024, QL = 512, KVL = 256, NQ = 1536, NKV = 2048, DINP = 3072;
constexpr float EPS = 1e-6f;
constexpr float LOG2E = 1.4426950408889634f;
constexpr int CH_L = 32, NCHUNK = T / CH_L;

constexpr size_t WS_WIN = 0;
constexpr size_t WS_WQ = WS_WIN + (size_t)DINP * DM * 2;
constexpr size_t WS_WKV = WS_WQ + (size_t)NQ * QL * 2;
constexpr size_t WS_WGATE = WS_WKV + (size_t)NKV * KVL * 2;
constexpr size_t WS_WOUT = WS_WGATE + (size_t)4096 * 128 * 2;
constexpr size_t WS_WGU = WS_WOUT + (size_t)DM * DM * 2;
constexpr size_t WS_WD = WS_WGU + (size_t)NGU * DM * 2;
constexpr size_t WS_ROPE = WS_WD + (size_t)DM * FF * 2;
constexpr size_t WS_CST = WS_ROPE + (size_t)8192 * 32 * 8;
constexpr size_t WS_SSQ = WS_CST + (size_t)2 * RG * 4;
constexpr size_t WS_CP = WS_SSQ + (size_t)T * 12 * 4;
constexpr size_t WS_CHH = WS_CP + (size_t)2 * NCHUNK * RG * 4;
constexpr size_t WS_CIN = WS_CHH + (size_t)2 * NCHUNK * RG * 4;
constexpr size_t WS_XN = WS_CIN + (size_t)2 * NCHUNK * RG * 4;
constexpr size_t WS_ACT = WS_XN + (size_t)T * DM * 2;
constexpr size_t HALFROW = (size_t)T * RG * 2;
constexpr size_t WS_GRG = WS_ACT;
constexpr size_t WS_QC = WS_GRG + HALFROW;
constexpr size_t WS_KVC = WS_QC + (size_t)T * QL * 2;
constexpr size_t WS_KR = WS_KVC + (size_t)T * KVL * 2;
constexpr size_t WS_XRG = WS_KR + (size_t)T * 64 * 2;
constexpr size_t WS_XC = WS_XRG + HALFROW;
constexpr size_t WS_LAB = WS_XC + HALFROW;
constexpr size_t WS_BB = WS_LAB + HALFROW;
constexpr size_t WS_Q = WS_XC;
constexpr size_t WS_KV = WS_Q + (size_t)T * NQ * 2;
constexpr size_t WS_END = WS_KV + (size_t)T * NKV * 2;
static_assert(WS_BB + HALFROW <= WS_END, "ws map");
static_assert(WS_XN % 256 == 0 && WS_ACT % 256 == 0 && WS_KR % 256 == 0 && WS_Q % 256 == 0 && WS_KV % 256 == 0, "ws align");

constexpr size_t WS_DBG = WS_END;
constexpr size_t WS_BAR = WS_END + 4096, BAR_BYTES = 16384;
constexpr int LDS_BYTES = 147456;

__device__ __forceinline__ unsigned cvt_pk_bf16(float lo, float hi) { unsigned r; asm volatile("v_cvt_pk_bf16_f32 %0, %1, %2" : "=v"(r) : "v"(lo), "v"(hi)); return r; }
__device__ __forceinline__ float bf_lo(unsigned w) { return __uint_as_float(w << 16); }
__device__ __forceinline__ float bf_hi(unsigned w) { return __uint_as_float(w & 0xffff0000u); }
__device__ __forceinline__ float sigmoidf_(float v) { return __builtin_amdgcn_rcpf(1.0f + __builtin_amdgcn_exp2f(-v * LOG2E)); }
__device__ __forceinline__ float wave_sum(float v) {
#pragma unroll
    for (int o = 1; o < 64; o <<= 1) v += __shfl_xor(v, o);
    return v;
}
__device__ __forceinline__ int row_pos(int row) { return row < TP ? (row & 2047) : (row - TP); }

namespace pg8 {
constexpr int BM = 256, BK = 64, HALF = 128, HTB = HALF * BK * 2, STAGE_BYTES = 8 * HTB, NXCD = 8, WGM = 8;
__device__ __forceinline__ int lds_byte(int r, int c) { const int st = (r >> 4) * 2 + (c >> 5), rr = r & 15, cc = c & 31, ob = rr * 64 + cc * 2; return st * 1024 + (ob ^ (((ob >> 9) & 1) << 5)); }
__device__ __forceinline__ void stage_rc(int b, int& R, int& C) { const int st = b / 1024, sb = b % 1024, swz = sb ^ (((sb >> 9) & 1) << 5); R = (st >> 1) * 16 + swz / 64; C = (st & 1) * 32 + (swz % 64) / 2; }
__device__ __forceinline__ int perm32(int rho) { const int n = rho >> 4, i = rho & 15; return 8 * (i >> 2) + 4 * n + (i & 3); }

struct Unit { int pm, pn; };
struct Gemm { const bf16_t* A; const bf16_t* Bt; int lda, ldb, K, nM, nN, amod, astep, ablk; };

struct StaticOrder {
    int nM, nN, nwg, G, c, tot, wgm;
    __device__ void init(int nM_, int nN_, int G_, int c_, int dup = 1, int wgm_ = WGM) { nM = nM_; nN = nN_; nwg = nM * nN; G = G_; c = c_; tot = nwg * dup; wgm = wgm_; }
    __device__ bool next(int i, Unit& u) const {
        const long L = (long)i * G + c; if (L >= tot) return false;
        int wgid = (int)(L % nwg); { const int q = nwg / NXCD, r = nwg % NXCD, xcd = wgid % NXCD, off = wgid / NXCD; wgid = (xcd < r ? xcd * (q + 1) : r * (q + 1) + (xcd - r) * q) + off; }
        const int nig = wgm * nN, gid = wgid / nig, fm = gid * wgm, gsz = (nM - fm) < wgm ? (nM - fm) : wgm;
        u.pm = fm + ((wgid % nig) % gsz); u.pn = (wgid % nig) / gsz; return true;
    }
};

template <class Epi>
__device__ __forceinline__ void gemm_phase(LAS unsigned char* lds, const Gemm g, const StaticOrder& S, const Epi& E) {
    const int tid = threadIdx.x, wid = __builtin_amdgcn_readfirstlane(tid >> 6), lane = tid & 63, wr = wid >> 2, wc = wid & 3, fr = lane & 15, fq = lane >> 4;
    const int K = g.K, nt = K / BK;
    unsigned voffA[2], voffB[2];
#pragma unroll
    for (int i = 0; i < 2; ++i) { int R, C; stage_rc(tid * 16 + i * 8192, R, C); const int Rb = Epi::PERM ? ((R & ~31) + perm32(R & 31)) : R;
        voffA[i] = g.ablk ? (unsigned)(tid * 16 + i * 8192) : (unsigned)(R * g.lda + C) * 2u; voffB[i] = (unsigned)(Rb * g.ldb + C) * 2u; }
    const size_t kstep = (size_t)(BK * 2), kstepA = g.ablk ? (size_t)HTB : kstep;
    const size_t hstepA = g.ablk ? (size_t)(K / BK) * HTB : (size_t)HALF * g.lda * 2, hstepB = (size_t)HALF * g.ldb * 2;
    const size_t tstepA = 2 * hstepA, tstepB = 2 * hstepB;
    const unsigned ldsw = (unsigned)wid * 1024u;
    const int aoff = lds_byte(wr * 64 + fr, fq * 8), boff = lds_byte(wc * 32 + fr, fq * 8);
#define PG8_SA(b, h) (((b) * 2 + (h)) * HTB)
#define PG8_SB(b, h) ((4 + (b) * 2 + (h)) * HTB)
#define PG8_STAGE(bufoff, gbase, voff) do { _Pragma("unroll") for (int _i = 0; _i < 2; ++_i) \
        __builtin_amdgcn_global_load_lds((const unsigned*)((const char*)(gbase) + (voff)[_i]), (LAS unsigned*)(lds + (bufoff) + ldsw + _i * 8192), 16, 0, 0); } while (0)
#define PG8_LDA(dst, b, h) do { _Pragma("unroll") for (int m = 0; m < 4; ++m) _Pragma("unroll") for (int k = 0; k < 2; ++k) dst[m][k] = *(const LAS bf16x8*)(lds + PG8_SA(b, h) + aoff + m * 2048 + k * 1024); } while (0)
#define PG8_LDB(dst, b, h) do { _Pragma("unroll") for (int n = 0; n < 2; ++n) _Pragma("unroll") for (int k = 0; k < 2; ++k) dst[n][k] = *(const LAS bf16x8*)(lds + PG8_SB(b, h) + boff + n * 2048 + k * 1024); } while (0)
#define PG8_MMA(ai, bj, At, Bt) do { __builtin_amdgcn_s_setprio(3); _Pragma("unroll") for (int m = 0; m < 4; ++m) _Pragma("unroll") for (int n = 0; n < 2; ++n) _Pragma("unroll") for (int k = 0; k < 2; ++k) \
        acc[ai][bj][m][n] = __builtin_amdgcn_mfma_f32_16x16x32_bf16(Bt[n][k], At[m][k], acc[ai][bj][m][n], 0, 0, 0); __builtin_amdgcn_s_setprio(0); } while (0)
#define PG8_WAIT_V(n) asm volatile("s_waitcnt vmcnt(" #n ")" ::: "memory")
#define PG8_WAIT_L(n) asm volatile("s_waitcnt lgkmcnt(" #n ")" ::: "memory")
#define PG8_BAR __builtin_amdgcn_s_barrier()
#define PG8_SCHED __builtin_amdgcn_sched_barrier(0)
#define PG8_APTR(u) ((const char*)g.A + (size_t)(u).pm * tstepA + (size_t)(((u).pn % g.amod) * g.astep) * 2)
#define PG8_BPTR(u) ((const char*)g.Bt + (size_t)(u).pn * tstepB)
    Unit cur, nxt; int ui = 0;
    if (!S.next(0, cur)) return;
    f32x4 acc[2][2][4][2];
#pragma unroll
    for (int a = 0; a < 2; ++a)
#pragma unroll
        for (int b = 0; b < 2; ++b)
#pragma unroll
            for (int m = 0; m < 4; ++m)
#pragma unroll
                for (int n = 0; n < 2; ++n) acc[a][b][m][n] = (f32x4){0.f, 0.f, 0.f, 0.f};
    bf16x8 At[4][2], B0[2][2], B1[2][2];
    const char* cA = PG8_APTR(cur); const char* cB = PG8_BPTR(cur);
    PG8_STAGE(PG8_SB(0, 0), cB, voffB); PG8_STAGE(PG8_SB(0, 1), cB + hstepB, voffB); PG8_STAGE(PG8_SA(0, 0), cA, voffA); PG8_STAGE(PG8_SA(0, 1), cA + hstepA, voffA);
    if (wr == 1) PG8_BAR;
    PG8_WAIT_V(2); PG8_BAR;
    PG8_STAGE(PG8_SB(1, 0), cB + kstep, voffB); PG8_STAGE(PG8_SA(1, 0), cA + kstepA, voffA); PG8_STAGE(PG8_SB(1, 1), cB + hstepB + kstep, voffB);
    PG8_WAIT_V(6); PG8_BAR;
    for (;;) {
        const bool has_next = S.next(ui + 1, nxt);
        const char* nA = has_next ? PG8_APTR(nxt) : cA; const char* nB = has_next ? PG8_BPTR(nxt) : cB;
        for (int t = 0; t < nt; t += 2) {
            const bool last = (t == nt - 2);
            const char* a1 = cA + (size_t)(t + 1) * kstepA;
            const char* a2 = last ? nA : cA + (size_t)(t + 2) * kstepA; const char* b2 = last ? nB : cB + (size_t)(t + 2) * kstep;
            const char* a3 = a2 + kstepA; const char* b3 = b2 + kstep;
            PG8_LDB(B0, 0, 0); PG8_LDB(B1, 0, 1); PG8_SCHED; PG8_LDA(At, 0, 0); PG8_STAGE(PG8_SA(1, 1), a1 + hstepA, voffA);
            PG8_WAIT_V(8); PG8_WAIT_L(0); PG8_BAR; PG8_MMA(0, 0, At, B0); PG8_MMA(0, 1, At, B1); PG8_BAR; PG8_SCHED;
            PG8_LDA(At, 0, 1); PG8_STAGE(PG8_SB(0, 0), b2, voffB); PG8_STAGE(PG8_SB(0, 1), b2 + hstepB, voffB); PG8_STAGE(PG8_SA(0, 0), a2, voffA);
            PG8_WAIT_V(8); PG8_WAIT_L(0); PG8_BAR; PG8_MMA(1, 0, At, B0); PG8_MMA(1, 1, At, B1); PG8_BAR; PG8_SCHED;
            PG8_LDB(B0, 1, 0); PG8_LDB(B1, 1, 1); PG8_SCHED; PG8_LDA(At, 1, 0); PG8_STAGE(PG8_SA(0, 1), a2 + hstepA, voffA);
            PG8_WAIT_V(8); PG8_WAIT_L(0); PG8_BAR; PG8_MMA(0, 0, At, B0); PG8_MMA(0, 1, At, B1); PG8_BAR; PG8_SCHED;
            PG8_LDA(At, 1, 1); PG8_STAGE(PG8_SB(1, 0), b3, voffB); PG8_STAGE(PG8_SB(1, 1), b3 + hstepB, voffB); PG8_STAGE(PG8_SA(1, 0), a3, voffA);
            PG8_WAIT_V(8); PG8_WAIT_L(0); PG8_BAR; PG8_MMA(1, 0, At, B0); PG8_MMA(1, 1, At, B1); PG8_BAR; PG8_SCHED;
        }
        if (wr == 0) PG8_BAR;
        PG8_SCHED; E(acc, cur, wr, wc, fr, fq); PG8_SCHED;
        if (!has_next) break;
#pragma unroll
        for (int a = 0; a < 2; ++a)
#pragma unroll
            for (int b = 0; b < 2; ++b)
#pragma unroll
                for (int m = 0; m < 4; ++m)
#pragma unroll
                    for (int n = 0; n < 2; ++n) acc[a][b][m][n] = (f32x4){0.f, 0.f, 0.f, 0.f};
        cur = nxt; cA = nA; cB = nB; ++ui;
        if (wr == 1) PG8_BAR;
    }
    PG8_WAIT_V(0);
    PG8_BAR;
#undef PG8_SA
#undef PG8_SB
#undef PG8_STAGE
#undef PG8_LDA
#undef PG8_LDB
#undef PG8_MMA
#undef PG8_WAIT_V
#undef PG8_WAIT_L
#undef PG8_BAR
#undef PG8_SCHED
#undef PG8_APTR
#undef PG8_BPTR
}

typedef const f32x4 (&AccRef)[2][2][4][2];

struct EpiSwiglu {
    static constexpr bool PERM = true;
    bf16_t* O;
    __device__ __forceinline__ void operator()(AccRef acc, const Unit& u, int wr, int wc, int fr, int fq) const {
        const int kt = u.pn * 2 + (wc >> 1); const int ob = fr * 64 + 16 * fq; const int inblk = ((wc & 1) * 1024) + (ob ^ (((ob >> 9) & 1) << 5));
#pragma unroll
        for (int ai = 0; ai < 2; ++ai)
#pragma unroll
            for (int m = 0; m < 4; ++m) {
                bf16_t* rowp = (bf16_t*)((char*)O + ((size_t)(u.pm * 2 + ai) * (FF / 64) + kt) * 16384 + (wr * 4 + m) * 2048 + inblk);
                const f32x4 g0 = acc[ai][0][m][0], g1 = acc[ai][0][m][1], u0 = acc[ai][1][m][0], u1 = acc[ai][1][m][1];
#define SWI2(G, U, a) ({ const f32x2 g_ = (f32x2){G[a], G[a + 1]}, u_ = (f32x2){U[a], U[a + 1]}; const f32x2 t_ = g_ * (-LOG2E); \
                    f32x2 d_; d_.x = __builtin_amdgcn_exp2f(t_.x); d_.y = __builtin_amdgcn_exp2f(t_.y); d_ = d_ + 1.0f; \
                    f32x2 r_; r_.x = __builtin_amdgcn_rcpf(d_.x); r_.y = __builtin_amdgcn_rcpf(d_.y); const f32x2 v_ = (g_ * u_) * r_; cvt_pk_bf16(v_.x, v_.y); })
                u32x4 w; w.x = SWI2(g0, u0, 0); w.y = SWI2(g0, u0, 2); w.z = SWI2(g1, u1, 0); w.w = SWI2(g1, u1, 2);
#undef SWI2
                *(u32x4*)rowp = w;
            }
    }
};
struct EpiResid {
    static constexpr bool PERM = false;
    const float* base0; const float* base1; float* out; float scale;
    __device__ __forceinline__ void operator()(AccRef acc, const Unit& u, int wr, int wc, int fr, int fq) const {
        const int rt = u.pm * BM; const float* bs = rt < TP ? base0 + (size_t)rt * DM : base1 + (size_t)(rt - TP) * DM; float* op = out + (size_t)rt * DM;
        const int col0 = u.pn * BM + wc * 32 + 4 * fq;
#pragma unroll
        for (int ai = 0; ai < 2; ++ai)
#pragma unroll
            for (int m = 0; m < 4; ++m) { const size_t off = (size_t)(ai * HALF + wr * 64 + m * 16 + fr) * DM + col0;
#pragma unroll
                for (int bj = 0; bj < 2; ++bj)
#pragma unroll
                    for (int n = 0; n < 2; ++n) { const f32x4 b = *(const f32x4*)(bs + off + bj * HALF + n * 16); *(f32x4*)(op + off + bj * HALF + n * 16) = b + acc[ai][bj][m][n] * scale; }
                if (m == 3) asm volatile("" ::: "memory"); }
    }
};
template <bool BF> struct EpiResidBf {
    static constexpr bool PERM = true;
    const float* base0; const float* base1; const bf16_t* baseb; bf16_t* xb; float scale;
    __device__ __forceinline__ void operator()(AccRef acc, const Unit& u, int wr, int wc, int fr, int fq) const {
        const int rt = u.pm * BM; const int col0 = u.pn * BM + wc * 32 + 8 * fq;
        const float* bs = rt < TP ? base0 : base1 - (size_t)TP * DM;
#pragma unroll
        for (int ai = 0; ai < 2; ++ai)
#pragma unroll
            for (int m = 0; m < 4; ++m) { const size_t off = (size_t)(rt + ai * HALF + wr * 64 + m * 16 + fr) * DM + col0;
#pragma unroll
                for (int bj = 0; bj < 2; ++bj) { f32x4 b0, b1;
                    if (BF) { const u32x4 w = *(const u32x4*)(baseb + off + bj * HALF); b0 = (f32x4){bf_lo(w.x), bf_hi(w.x), bf_lo(w.y), bf_hi(w.y)}; b1 = (f32x4){bf_lo(w.z), bf_hi(w.z), bf_lo(w.w), bf_hi(w.w)}; }
                    else { b0 = *(const f32x4*)(bs + off + bj * HALF); b1 = *(const f32x4*)(bs + off + bj * HALF + 4); }
                    const f32x4 v0 = b0 + acc[ai][bj][m][0] * scale, v1 = b1 + acc[ai][bj][m][1] * scale;
                    u32x4 w; w.x = cvt_pk_bf16(v0[0], v0[1]); w.y = cvt_pk_bf16(v0[2], v0[3]); w.z = cvt_pk_bf16(v1[0], v1[1]); w.w = cvt_pk_bf16(v1[2], v1[3]);
                    *(u32x4*)(xb + off + bj * HALF) = w; }
                if (m == 3) asm volatile("" ::: "memory"); }
    }
};
struct EpiWin {
    static constexpr bool PERM = true;
    bf16_t *xrg, *grg, *qc, *kvc, *kr; float* ssq; const f32x2* rope;
    __device__ __forceinline__ void operator()(AccRef acc, const Unit& u, int wr, int wc, int fr, int fq) const {
        const int row0 = u.pm * BM + wr * 64 + fr; const int pn = u.pn;
        if (pn < 11) {
            bf16_t* dst; int ld, cb;
            if (pn < 4) { dst = xrg; ld = RG; cb = 256 * pn; } else if (pn < 8) { dst = grg; ld = RG; cb = 256 * (pn - 4); } else if (pn < 10) { dst = qc; ld = QL; cb = 256 * (pn - 8); } else { dst = kvc; ld = KVL; cb = 0; }
            const int col0 = cb + wc * 32 + 8 * fq;
#pragma unroll
            for (int ai = 0; ai < 2; ++ai)
#pragma unroll
                for (int m = 0; m < 4; ++m) { const int row = row0 + ai * HALF + m * 16; float s = 0.f;
#pragma unroll
                    for (int bj = 0; bj < 2; ++bj) { const f32x4 v0 = acc[ai][bj][m][0], v1 = acc[ai][bj][m][1];
                        s += (v0[0] * v0[0] + v0[1] * v0[1]) + (v0[2] * v0[2] + v0[3] * v0[3]) + (v1[0] * v1[0] + v1[1] * v1[1]) + (v1[2] * v1[2] + v1[3] * v1[3]);
                        u32x4 w; w.x = cvt_pk_bf16(v0[0], v0[1]); w.y = cvt_pk_bf16(v0[2], v0[3]); w.z = cvt_pk_bf16(v1[0], v1[1]); w.w = cvt_pk_bf16(v1[2], v1[3]);
                        *(u32x4*)(dst + (size_t)row * ld + col0 + bj * HALF) = w; }
                    if (pn >= 8) { s += __shfl_xor(s, 16); s += __shfl_xor(s, 32); if (fq == 0) ssq[(size_t)row * 12 + (pn - 8) * 4 + wc] = s; }
                }
        } else if (wc == 0) {
#pragma unroll
            for (int ai = 0; ai < 2; ++ai)
#pragma unroll
                for (int m = 0; m < 4; ++m) { const int row = row0 + ai * HALF + m * 16; const int pos = row_pos(row);
                    const f32x2* rp = rope + (size_t)pos * 32 + 8 * fq; float o1[8], o2[8];
#pragma unroll
                    for (int n = 0; n < 2; ++n)
#pragma unroll
                        for (int j = 0; j < 4; ++j) { const f32x2 cs = rp[4 * n + j]; const float x1 = acc[ai][0][m][n][j], x2 = acc[ai][1][m][n][j]; o1[4 * n + j] = x1 * cs.x - x2 * cs.y; o2[4 * n + j] = x2 * cs.x + x1 * cs.y; }
                    u32x4 w1, w2; w1.x = cvt_pk_bf16(o1[0], o1[1]); w1.y = cvt_pk_bf16(o1[2], o1[3]); w1.z = cvt_pk_bf16(o1[4], o1[5]); w1.w = cvt_pk_bf16(o1[6], o1[7]);
                    w2.x = cvt_pk_bf16(o2[0], o2[1]); w2.y = cvt_pk_bf16(o2[2], o2[3]); w2.z = cvt_pk_bf16(o2[4], o2[5]); w2.w = cvt_pk_bf16(o2[6], o2[7]);
                    *(u32x4*)(kr + (size_t)row * 64 + 8 * fq) = w1; *(u32x4*)(kr + (size_t)row * 64 + 32 + 8 * fq) = w2; }
        }
    }
};
struct EpiQ {
    static constexpr bool PERM = true;
    bf16_t* Q; const float* ssq; const f32x2* rope;
    __device__ __forceinline__ void operator()(AccRef acc, const Unit& u, int wr, int wc, int fr, int fq) const {
        const int row0 = u.pm * BM + wr * 64 + fr; const int pn = u.pn;
#pragma unroll
        for (int ai = 0; ai < 2; ++ai)
#pragma unroll
            for (int m = 0; m < 4; ++m) { const int row = row0 + ai * HALF + m * 16;
                const f32x4 sa = *(const f32x4*)(ssq + (size_t)row * 12), sb = *(const f32x4*)(ssq + (size_t)row * 12 + 4);
                const float rstd = __builtin_amdgcn_rsqf(((sa[0] + sa[1]) + (sa[2] + sa[3]) + (sb[0] + sb[1]) + (sb[2] + sb[3])) * (1.0f / QL) + EPS);
                bf16_t* qrow = Q + (size_t)row * NQ;
                if (pn < 4) {
#pragma unroll
                    for (int bj = 0; bj < 2; ++bj) { const f32x4 v0 = acc[ai][bj][m][0] * rstd, v1 = acc[ai][bj][m][1] * rstd;
                        u32x4 w; w.x = cvt_pk_bf16(v0[0], v0[1]); w.y = cvt_pk_bf16(v0[2], v0[3]); w.z = cvt_pk_bf16(v1[0], v1[1]); w.w = cvt_pk_bf16(v1[2], v1[3]);
                        *(u32x4*)(qrow + (2 * pn + bj) * 192 + wc * 32 + 8 * fq) = w; }
                } else {
                    const int h = 4 * (pn - 4) + wc; const int pos = row_pos(row); const f32x2* rp = rope + (size_t)pos * 32 + 8 * fq; float o1[8], o2[8];
#pragma unroll
                    for (int n = 0; n < 2; ++n)
#pragma unroll
                        for (int j = 0; j < 4; ++j) { const f32x2 cs = rp[4 * n + j]; const float x1 = acc[ai][0][m][n][j] * rstd, x2 = acc[ai][1][m][n][j] * rstd; o1[4 * n + j] = x1 * cs.x - x2 * cs.y; o2[4 * n + j] = x2 * cs.x + x1 * cs.y; }
                    u32x4 w1, w2; w1.x = cvt_pk_bf16(o1[0], o1[1]); w1.y = cvt_pk_bf16(o1[2], o1[3]); w1.z = cvt_pk_bf16(o1[4], o1[5]); w1.w = cvt_pk_bf16(o1[6], o1[7]);
                    w2.x = cvt_pk_bf16(o2[0], o2[1]); w2.y = cvt_pk_bf16(o2[2], o2[3]); w2.z = cvt_pk_bf16(o2[4], o2[5]); w2.w = cvt_pk_bf16(o2[6], o2[7]);
                    *(u32x4*)(qrow + h * 192 + 128 + 8 * fq) = w1; *(u32x4*)(qrow + h * 192 + 160 + 8 * fq) = w2;
                }
            }
    }
};
struct EpiKV {
    static constexpr bool PERM = true;
    bf16_t* KV; const float* ssq;
    __device__ __forceinline__ void operator()(AccRef acc, const Unit& u, int wr, int wc, int fr, int fq) const {
        const int row0 = u.pm * BM + wr * 64 + fr; const int col0 = u.pn * BM + wc * 32 + 8 * fq;
#pragma unroll
        for (int ai = 0; ai < 2; ++ai)
#pragma unroll
            for (int m = 0; m < 4; ++m) { const int row = row0 + ai * HALF + m * 16;
                const f32x4 sa = *(const f32x4*)(ssq + (size_t)row * 12 + 8);
                const float rstd = __builtin_amdgcn_rsqf(((sa[0] + sa[1]) + (sa[2] + sa[3])) * (1.0f / KVL) + EPS);
#pragma unroll
                for (int bj = 0; bj < 2; ++bj) { const f32x4 v0 = acc[ai][bj][m][0] * rstd, v1 = acc[ai][bj][m][1] * rstd;
                    u32x4 w; w.x = cvt_pk_bf16(v0[0], v0[1]); w.y = cvt_pk_bf16(v0[2], v0[3]); w.z = cvt_pk_bf16(v1[0], v1[1]); w.w = cvt_pk_bf16(v1[2], v1[3]);
                    *(u32x4*)(KV + (size_t)row * NKV + col0 + bj * HALF) = w; }
            }
    }
};
struct EpiGates {
    static constexpr bool PERM = true;
    const bf16_t* xc; _Float16 *laf, *bf, *lab, *bb; const float *b_a, *b_x, *cst;
    __device__ __forceinline__ void operator()(AccRef acc, const Unit& u, int wr, int wc, int fr, int fq) const {
        const int dir = u.pn >> 3, cg_ = u.pn & 7; const int c0 = cg_ * 128 + wc * 32 + 8 * fq; const int row0 = u.pm * BM + wr * 64 + fr;
        char* LA = (char*)(dir ? lab : laf); char* BBp = (char*)(dir ? bb : bf); const char* xcp = (const char*)xc;
        const unsigned off0 = (unsigned)(row0 * RG + c0) * 2u;
#pragma unroll
        for (int n = 0; n < 2; ++n) {
            const f32x4 ba = *(const f32x4*)(b_a + dir * RG + c0 + 4 * n), bx = *(const f32x4*)(b_x + dir * RG + c0 + 4 * n), cs = *(const f32x4*)(cst + dir * RG + c0 + 4 * n);
#pragma unroll
            for (int ai = 0; ai < 2; ++ai)
#pragma unroll
                for (int m = 0; m < 4; ++m) { const unsigned off = off0 + (unsigned)(((ai * HALF + m * 16) * RG + 4 * n) * 2);
                    const u32x2 xw = *(const u32x2*)(xcp + off);
                    h16x2 la0, la1, bo0, bo1;
#pragma unroll
                    for (int j = 0; j < 4; ++j) { const unsigned w = xw[j >> 1]; const float xv = (j & 1) ? bf_hi(w) : bf_lo(w);
                        const float r = sigmoidf_(acc[ai][0][m][n][j] + ba[j]), ig = sigmoidf_(acc[ai][1][m][n][j] + bx[j]);
                        const float l2 = r * cs[j];
                        const float x = 2.0f * l2 * 0.6931471805599453f;
                        const float om = (x > -0.02f) ? -x * (1.0f + x * (0.5f + x * (1.0f / 6.0f))) : 1.0f - __builtin_amdgcn_exp2f(2.0f * l2);
                        const _Float16 lh = (_Float16)l2, bh = (_Float16)(__builtin_amdgcn_sqrtf(om) * ig * xv);
                        if (j < 2) { la0[j] = lh; bo0[j] = bh; } else { la1[j - 2] = lh; bo1[j - 2] = bh; } }
                    u32x2 lw, bw; lw.x = __builtin_bit_cast(unsigned, la0); lw.y = __builtin_bit_cast(unsigned, la1); bw.x = __builtin_bit_cast(unsigned, bo0); bw.y = __builtin_bit_cast(unsigned, bo1);
                    *(u32x2*)(LA + off) = lw; *(u32x2*)(BBp + off) = bw;
                    asm volatile("" ::: "memory");
                }
        }
    }
};
}

namespace att {
constexpr int KSLOT = 64 * 192 * 2, VSLOT = 64 * 128 * 2;
constexpr int LDS_K = 0, LDS_V = 2 * KSLOT, LDS_WS = LDS_V + 3 * VSLOT, LDS_TOT = LDS_WS + 8 * 64 * 4;
constexpr float SCALE = 0.07216878364870322f;
constexpr float THR = 8.f;
#define SBAR() __builtin_amdgcn_sched_barrier(0)
__device__ __forceinline__ int crow(int r, int hi) { return (r & 3) + 8 * (r >> 2) + 4 * hi; }

__device__ __forceinline__ void partialSM(f32x16& p0, f32x16& p1, float& m_reg, float& alpha) {
    constexpr float C = SCALE * LOG2E;
    float pmax = p0[0];
#pragma unroll
    for (int r = 1; r < 16; ++r) pmax = fmaxf(pmax, p0[r]);
#pragma unroll
    for (int r = 0; r < 16; ++r) pmax = fmaxf(pmax, p1[r]);
    { auto rr = __builtin_amdgcn_permlane32_swap(__float_as_uint(pmax), __float_as_uint(pmax), false, false); pmax = fmaxf(__uint_as_float(rr[0]), __uint_as_float(rr[1])); }
    float mn;
    if (__builtin_expect(__all(pmax - m_reg <= THR / SCALE), 1)) { mn = m_reg; alpha = 1.f; }
    else { mn = fmaxf(m_reg, pmax); alpha = __builtin_amdgcn_exp2f((m_reg - mn) * C); m_reg = mn; }
    const float mnC = -mn * C;
#pragma unroll
    for (int r = 0; r < 16; ++r) p0[r] = fmaf(p0[r], C, mnC);
#pragma unroll
    for (int r = 0; r < 16; ++r) p1[r] = fmaf(p1[r], C, mnC);
#pragma unroll
    for (int r = 0; r < 16; ++r) p0[r] = __builtin_amdgcn_exp2f(p0[r]);
}
__device__ __forceinline__ void finishSM(f32x16& p0, f32x16& p1, float alpha, float& l_reg, bf16x8& pa0, bf16x8& pa1, bf16x8& pa2, bf16x8& pa3) {
#pragma unroll
    for (int r = 0; r < 16; ++r) p1[r] = __builtin_amdgcn_exp2f(p1[r]);
    float ps = 0;
#pragma unroll
    for (int r = 0; r < 16; ++r) ps += p0[r];
#pragma unroll
    for (int r = 0; r < 16; ++r) ps += p1[r];
    { auto rr = __builtin_amdgcn_permlane32_swap(__float_as_uint(ps), __float_as_uint(ps), false, false); ps = __uint_as_float(rr[0]) + __uint_as_float(rr[1]); }
    l_reg = l_reg * alpha + ps;
#define PK4(P, BASE, OUT) do { unsigned a0 = cvt_pk_bf16(P[BASE + 0], P[BASE + 1]), a1 = cvt_pk_bf16(P[BASE + 2], P[BASE + 3]);   \
    unsigned b0 = cvt_pk_bf16(P[BASE + 4], P[BASE + 5]), b1 = cvt_pk_bf16(P[BASE + 6], P[BASE + 7]);                              \
    auto r0 = __builtin_amdgcn_permlane32_swap(a0, b0, false, false); auto r1 = __builtin_amdgcn_permlane32_swap(a1, b1, false, false); \
    u32x4 w = {r0[0], r1[0], r0[1], r1[1]}; OUT = __builtin_bit_cast(bf16x8, w); } while (0)
    PK4(p0, 0, pa0); PK4(p0, 8, pa1); PK4(p1, 0, pa2); PK4(p1, 8, pa3);
#undef PK4
}
__device__ __forceinline__ void qkt(f32x16& p0, f32x16& p1, const LAS unsigned char* Ks, const bf16x8 (&qr)[12], int r32, int hi) {
    p0 = f32x16{}; p1 = f32x16{};
    const int sw = (r32 & 7) << 4;
#pragma unroll
    for (int d0 = 0; d0 < 12; ++d0) { const int cb = (d0 * 16 + hi * 8) * 2;
        const bf16x8 b0 = *(const LAS bf16x8*)(Ks + r32 * 384 + (cb ^ sw));
        const bf16x8 b1 = *(const LAS bf16x8*)(Ks + (32 + r32) * 384 + (cb ^ sw));
        p0 = __builtin_amdgcn_mfma_f32_32x32x16_bf16(b0, qr[d0], p0, 0, 0, 0);
        p1 = __builtin_amdgcn_mfma_f32_32x32x16_bf16(b1, qr[d0], p1, 0, 0, 0); }
}
__device__ __forceinline__ int v_rd_base(int lane) { return ((lane & 3) << 3) | (((lane >> 2) & 3) << 6) | (((lane >> 4) & 1) << 5) | (((lane >> 5) & 1) << 8); }
constexpr int v_rd_off(int d0, int ks, int half) { return d0 * 512 + ks * 4096 + half * 2048; }
template <int OFF> __device__ __forceinline__ s16x4 tr_read(int vb) { s16x4 r; asm volatile("ds_read_b64_tr_b16 %0, %1 offset:%2" : "=&v"(r) : "v"(vb), "i"(OFF) : "memory"); return r; }
template <int KS> __device__ __forceinline__ void pv_ks(f32x16 (&o)[4], int vb, bf16x8 pa) {
    const s16x4 l0 = tr_read<v_rd_off(0, KS, 0)>(vb), h0 = tr_read<v_rd_off(0, KS, 1)>(vb), l1 = tr_read<v_rd_off(1, KS, 0)>(vb), h1 = tr_read<v_rd_off(1, KS, 1)>(vb);
    const s16x4 l2 = tr_read<v_rd_off(2, KS, 0)>(vb), h2 = tr_read<v_rd_off(2, KS, 1)>(vb), l3 = tr_read<v_rd_off(3, KS, 0)>(vb), h3 = tr_read<v_rd_off(3, KS, 1)>(vb);
    asm volatile("s_waitcnt lgkmcnt(0)" ::: "memory"); SBAR();
#define PK(L, H) (bf16x8){L[0], L[1], L[2], L[3], H[0], H[1], H[2], H[3]}
    o[0] = __builtin_amdgcn_mfma_f32_32x32x16_bf16(pa, PK(l0, h0), o[0], 0, 0, 0);
    o[1] = __builtin_amdgcn_mfma_f32_32x32x16_bf16(pa, PK(l1, h1), o[1], 0, 0, 0);
    o[2] = __builtin_amdgcn_mfma_f32_32x32x16_bf16(pa, PK(l2, h2), o[2], 0, 0, 0);
    o[3] = __builtin_amdgcn_mfma_f32_32x32x16_bf16(pa, PK(l3, h3), o[3], 0, 0, 0);
#undef PK
}
__device__ __forceinline__ void pv_d0(f32x16 (&o)[4], int vb, bf16x8 pa0, bf16x8 pa1, bf16x8 pa2, bf16x8 pa3) {
    pv_ks<0>(o, vb, pa0); pv_ks<1>(o, vb, pa1); pv_ks<2>(o, vb, pa2); pv_ks<3>(o, vb, pa3);
}

__device__ __forceinline__ void attn_unit(LAS unsigned char* lds, const bf16_t* __restrict__ Q, const bf16_t* __restrict__ KV, const bf16_t* __restrict__ KR, bf16_t* __restrict__ O,
                                          int qrow0, int krow0, int seq, int h) {
    const int tid = threadIdx.x, lane = tid & 63, r32 = lane & 31, hi = lane >> 5; const int wid = __builtin_amdgcn_readfirstlane(tid >> 6);
    LAS float* wsf = (LAS float*)(lds + LDS_WS) + wid * 64; LAS float* li_l = wsf; LAS float* al_l = wsf + 32;
    const char* base = (const char*)KV;
    const int krdiff = (int)((const char*)KR - (const char*)KV);
    int ksrc[3]; int kstep[3];
#pragma unroll
    for (int i = 0; i < 3; ++i) { const int p = (i * 8 + wid) * 64 + lane; const int row = p / 24, slot = p % 24, ck = slot ^ (row & 7);
        if (ck < 16) { ksrc[i] = ((krow0 + row) * NKV + h * 256 + ck * 8) * 2; kstep[i] = 64 * NKV * 2; }
        else { ksrc[i] = krdiff + ((krow0 + row) * 64 + (ck - 16) * 8) * 2; kstep[i] = 64 * 64 * 2; } }
    int vsrc[2];
#pragma unroll
    for (int i = 0; i < 2; ++i) { const int j = (i * 8 + wid) * 64 + lane; const int s = j >> 5, kk = (s >> 2) * 8 + ((j >> 2) & 7), c = (s & 3) * 32 + (j & 3) * 8;
        const int k = (kk & ~0xC) | ((kk & 4) << 1) | ((kk & 8) >> 1);
        vsrc[i] = ((krow0 + k) * NKV + h * 256 + 128 + c) * 2; }
#define DMA_K(t, ks) do { _Pragma("unroll") for (int _i = 0; _i < 3; ++_i) \
        __builtin_amdgcn_global_load_lds((const unsigned*)(base + (ksrc[_i] + (t) * kstep[_i])), (LAS unsigned*)(lds + LDS_K + (ks) * KSLOT + (_i * 8 + wid) * 1024), 16, 0, 0); } while (0)
#define DMA_V(t, voff) do { _Pragma("unroll") for (int _i = 0; _i < 2; ++_i) \
        __builtin_amdgcn_global_load_lds((const unsigned*)(base + (vsrc[_i] + (t) * (64 * NKV * 2))), (LAS unsigned*)(lds + LDS_V + (voff) + (_i * 8 + wid) * 1024), 16, 0, 0); } while (0)
#define SYNC_ALL() do { asm volatile("s_waitcnt vmcnt(0) lgkmcnt(0)" ::: "memory"); __syncthreads(); } while (0)
#define RESC(a) do { if (__any((a) < 1.f)) { if (hi == 0) al_l[r32] = (a); asm volatile("s_waitcnt lgkmcnt(0)" ::: "memory"); \
        _Pragma("unroll") for (int d = 0; d < 4; ++d) _Pragma("unroll") for (int r = 0; r < 16; ++r) o[d][r] *= al_l[crow(r, hi)]; } } while (0)
    const int NT = seq / 64;
    DMA_K(0, 0); DMA_V(0, 0);
    bf16x8 qr[12];
    { const bf16_t* Qw = Q + (size_t)(qrow0 + wid * 32 + r32) * NQ + h * 192 + hi * 8;
#pragma unroll
      for (int d0 = 0; d0 < 12; ++d0) qr[d0] = *(const bf16x8*)(Qw + d0 * 16); }
    float m_reg = -1e30f, l_reg = 0.f; f32x16 o[4];
#pragma unroll
    for (int d = 0; d < 4; ++d) o[d] = f32x16{};
    const int vb0 = (int)(uintptr_t)(lds + LDS_V) + v_rd_base(lane);
    f32x16 pA0, pA1, pB0, pB1; float alA, alB; bf16x8 pa0, pa1, pa2, pa3;
    SYNC_ALL();
    DMA_K(1, 1); DMA_V(1, VSLOT);
    qkt(pA0, pA1, lds + LDS_K, qr, r32, hi); partialSM(pA0, pA1, m_reg, alA);
    int vs_prev = 0, vs_cur = VSLOT, vs_next = 2 * VSLOT;
#define ROT() do { const int _t = vs_prev; vs_prev = vs_cur; vs_cur = vs_next; vs_next = _t; } while (0)
    for (int j = 1; j + 1 < NT; j += 2) {
        SYNC_ALL();
        DMA_K(j + 1, 0); DMA_V(j + 1, vs_next);
        SBAR(); qkt(pB0, pB1, lds + LDS_K + KSLOT, qr, r32, hi);
        finishSM(pA0, pA1, alA, l_reg, pa0, pa1, pa2, pa3); SBAR();
        pv_d0(o, vb0 + vs_prev, pa0, pa1, pa2, pa3); partialSM(pB0, pB1, m_reg, alB);
        RESC(alB); ROT();
        SYNC_ALL();
        if (j + 2 < NT) { DMA_K(j + 2, 1); DMA_V(j + 2, vs_next); }
        SBAR(); qkt(pA0, pA1, lds + LDS_K, qr, r32, hi);
        finishSM(pB0, pB1, alB, l_reg, pa0, pa1, pa2, pa3); SBAR();
        pv_d0(o, vb0 + vs_prev, pa0, pa1, pa2, pa3); partialSM(pA0, pA1, m_reg, alA);
        RESC(alA); ROT();
    }
    SYNC_ALL();
    SBAR(); qkt(pB0, pB1, lds + LDS_K + KSLOT, qr, r32, hi);
    finishSM(pA0, pA1, alA, l_reg, pa0, pa1, pa2, pa3); SBAR();
    pv_d0(o, vb0 + vs_prev, pa0, pa1, pa2, pa3); partialSM(pB0, pB1, m_reg, alB);
    RESC(alB);
    finishSM(pB0, pB1, alB, l_reg, pa0, pa1, pa2, pa3); SBAR();
    pv_d0(o, vb0 + vs_cur, pa0, pa1, pa2, pa3);
    if (hi == 0) li_l[r32] = l_reg; asm volatile("s_waitcnt lgkmcnt(0)" ::: "memory");
    float rli[16];
#pragma unroll
    for (int r = 0; r < 16; ++r) rli[r] = __builtin_amdgcn_rcpf(li_l[crow(r, hi)]);
    bf16_t* Ow = O + (size_t)(qrow0 + wid * 32) * RG + h * 128;
#pragma unroll
    for (int r = 0; r < 16; ++r) { const int orow = crow(r, hi);
#pragma unroll
        for (int d0 = 0; d0 < 4; ++d0) Ow[(size_t)orow * RG + d0 * 32 + r32] = (bf16_t)(cvt_pk_bf16(o[d0][r] * rli[r], 0.f) & 0xffffu); }
    SYNC_ALL();
#undef DMA_K
#undef DMA_V
#undef SYNC_ALL
#undef RESC
#undef ROT
}
#undef SBAR
}


#define XB_TMO      128
#define XB_XCNT(j)  (256  + 64 * (j))
#define XB_XSUB(j)  (1280 + 64 * (j))
#define XB_XGEN(j)  (2304 + 64 * (j))
#define XB_TOP      3328
#define XB_TOPGEN   3392
#define XCD_BAR_WORDS 3456
#define XB_SPIN_CAP (1u << 18)
__device__ __forceinline__ unsigned xb_ld(unsigned* p)              { return __hip_atomic_load(p, __ATOMIC_RELAXED, __HIP_MEMORY_SCOPE_AGENT); }
__device__ __forceinline__ unsigned xb_add(unsigned* p, unsigned v) { return __hip_atomic_fetch_add(p, v, __ATOMIC_RELAXED, __HIP_MEMORY_SCOPE_AGENT); }
__device__ __forceinline__ unsigned xb_xcc_id() { return (unsigned)__builtin_amdgcn_s_getreg((3 << 11) | 20) & 0xFu; }
#define XB_SPIN(cond, bar) do { unsigned _sp = 0; while (cond) { \
    if ((++_sp & 255u) == 0u) { if (xb_ld(&(bar)[XB_TMO])) break; if (_sp > XB_SPIN_CAP) { atomicAdd(&(bar)[XB_TMO], 1u); break; } } } } while (0)
__device__ __forceinline__ void xcd_barrier_post(unsigned* bar) { if (threadIdx.x == 0) (void)xb_add(&bar[XB_XCNT(xb_xcc_id())], 1u); }
__device__ __forceinline__ void xcd_barrier_complete(unsigned* bar, unsigned x, unsigned& nloc, unsigned& nx) {
    const unsigned G = gridDim.x * gridDim.y * gridDim.z;
    unsigned sum, cnt, mine, sp = 0u;
    for (;;) {
        sum = 0u; cnt = 0u; mine = 0u;
#pragma unroll
        for (unsigned j = 0; j < 16; ++j) { const unsigned c = xb_ld(&bar[XB_XCNT(j)]); sum += c; cnt += (c > 0u) ? 1u : 0u; mine = (j == x) ? c : mine; }
        if (sum == G) break;
        __builtin_amdgcn_s_sleep(1);
        if ((++sp & 255u) == 0u) { if (xb_ld(&bar[XB_TMO])) break; if (sp > XB_SPIN_CAP) { atomicAdd(&bar[XB_TMO], 1u); break; } }
    }
    nloc = mine > 0u ? mine : 1u; nx = cnt > 0u ? cnt : 1u;
}
__device__ __forceinline__ void xcd_barrier(unsigned* bar, volatile LAS unsigned* st) {
    asm volatile("s_waitcnt vmcnt(0)" ::: "memory");
    __syncthreads();
    if (threadIdx.x == 0) {
        const unsigned x = xb_xcc_id();
        __builtin_amdgcn_s_waitcnt(0);
        unsigned nloc = st[0], nx = st[1];
        if (nloc == 0u) { xcd_barrier_complete(bar, x, nloc, nx); st[0] = nloc; st[1] = nx; }
        const unsigned old = xb_add(&bar[XB_XSUB(x)], 1u);
        const unsigned gen = old / nloc;
        if (old + 1u == (gen + 1u) * nloc) {
            __builtin_amdgcn_fence(__ATOMIC_RELEASE, "agent");
            asm volatile("s_waitcnt vmcnt(0)" ::: "memory");
            const unsigned og = xb_add(&bar[XB_TOP], 1u);
            const unsigned tg = og / nx;
            if (og + 1u == (tg + 1u) * nx) xb_add(&bar[XB_TOPGEN], 1u);
            else XB_SPIN(xb_ld(&bar[XB_TOPGEN]) == tg, bar);
            __builtin_amdgcn_fence(__ATOMIC_ACQUIRE, "agent");
            xb_add(&bar[XB_XGEN(x)], 1u);
            asm volatile("s_waitcnt vmcnt(0)" ::: "memory");
        } else {
            XB_SPIN(xb_ld(&bar[XB_XGEN(x)]) == gen, bar);
            __builtin_amdgcn_fence(__ATOMIC_ACQUIRE, "agent");
            asm volatile("s_waitcnt vmcnt(0)" ::: "memory");
        }
    }
    __syncthreads();
}
struct MapId { __device__ __forceinline__ int operator()(int n) const { return n; } };
struct MapGU { int off; __device__ __forceinline__ int operator()(int n) const { return (n >> 7) * 256 + off + (n & 127); } };
struct MapWin { __device__ __forceinline__ int operator()(int n) const { if (n < 2816) return n; const int i = n - 2816; return 2816 + (i < 32 ? i : 128 + (i - 32)); } };
struct MapQ { __device__ __forceinline__ int operator()(int n) const { const int h = n / 192, d = n - h * 192; if (d < 128) return h * 128 + d; const int i = d - 128;
    return 1024 + (h >> 2) * 256 + (h & 3) * 32 + (i & 31) + ((i >> 5) << 7); } };

template <class MapN>
__device__ __forceinline__ void transpose_item(const float* __restrict__ W, int N, const float* __restrict__ kscale, bf16_t* __restrict__ WT, int ldt, MapN mapn, LAS float* scr, int item, int lane) {
    const int nblk = N / 32, kb = item / nblk, nb = item - kb * nblk, k0 = 64 * kb, n0 = 32 * nb;
#pragma unroll 8
    for (int i = 0; i < 32; ++i) { const int kk = 2 * i + (lane >> 5); float v = W[(size_t)(k0 + kk) * N + n0 + (lane & 31)]; if (kscale) v *= kscale[k0 + kk]; scr[kk * 33 + (lane & 31)] = v; }
    asm volatile("s_waitcnt lgkmcnt(0)" ::: "memory");
    const int c = lane & 7;
#pragma unroll
    for (int j = 0; j < 4; ++j) { const int n = (lane >> 3) + 8 * j; const LAS float* s = scr + (8 * c) * 33 + n;
        u32x4 o; o.x = cvt_pk_bf16(s[0 * 33], s[1 * 33]); o.y = cvt_pk_bf16(s[2 * 33], s[3 * 33]); o.z = cvt_pk_bf16(s[4 * 33], s[5 * 33]); o.w = cvt_pk_bf16(s[6 * 33], s[7 * 33]);
        *(u32x4*)(WT + (size_t)mapn(n0 + n) * ldt + k0 + 8 * c) = o; }
    asm volatile("s_waitcnt lgkmcnt(0)" ::: "memory");
}
__device__ __forceinline__ void rms_row_to_bf16(const float* __restrict__ xrow, const float* __restrict__ g, bf16_t* __restrict__ orow, int lane) {
    const f32x4* xr = (const f32x4*)xrow + lane; const f32x4* gr = (const f32x4*)g + lane;
    f32x4 v[8]; float s = 0.f;
#pragma unroll
    for (int j = 0; j < 8; ++j) { v[j] = xr[64 * j]; s += (v[j].x * v[j].x + v[j].y * v[j].y) + (v[j].z * v[j].z + v[j].w * v[j].w); }
    const float rstd = __builtin_amdgcn_rsqf(wave_sum(s) * (1.f / DM) + EPS);
    u32x2* o8 = (u32x2*)orow + lane;
#pragma unroll
    for (int j = 0; j < 8; ++j) { const f32x4 gg = gr[64 * j]; u32x2 w; w.x = cvt_pk_bf16(v[j].x * rstd * gg.x, v[j].y * rstd * gg.y); w.y = cvt_pk_bf16(v[j].z * rstd * gg.z, v[j].w * rstd * gg.w); o8[64 * j] = w; }
}
__device__ __forceinline__ void rms_rowbf_to_bf16(const bf16_t* __restrict__ xrow, const float* __restrict__ g, bf16_t* __restrict__ orow, int lane) {
    const u32x4* xr = (const u32x4*)xrow + lane; float v[4][8]; float s = 0.f;
#pragma unroll
    for (int j = 0; j < 4; ++j) { const u32x4 w = xr[64 * j];
#pragma unroll
        for (int q = 0; q < 4; ++q) { v[j][2 * q] = bf_lo(w[q]); v[j][2 * q + 1] = bf_hi(w[q]); s += v[j][2 * q] * v[j][2 * q] + v[j][2 * q + 1] * v[j][2 * q + 1]; } }
    const float rstd = __builtin_amdgcn_rsqf(wave_sum(s) * (1.f / DM) + EPS);
#pragma unroll
    for (int j = 0; j < 4; ++j) { const int c = 8 * (lane + 64 * j); const f32x4 g0 = *(const f32x4*)(g + c), g1 = *(const f32x4*)(g + c + 4); u32x4 w;
        w.x = cvt_pk_bf16(v[j][0] * rstd * g0[0], v[j][1] * rstd * g0[1]); w.y = cvt_pk_bf16(v[j][2] * rstd * g0[2], v[j][3] * rstd * g0[3]);
        w.z = cvt_pk_bf16(v[j][4] * rstd * g1[0], v[j][5] * rstd * g1[1]); w.w = cvt_pk_bf16(v[j][6] * rstd * g1[2], v[j][7] * rstd * g1[3]);
        *(u32x4*)(orow + c) = w; }
}
__device__ __forceinline__ float gelu_tanh(float x) { const float u2 = 2.0f * 0.7978845608028654f * (x + 0.044715f * x * x * x); return x * __builtin_amdgcn_rcpf(1.0f + __builtin_amdgcn_exp2f(-u2 * LOG2E)); }


#ifdef MK_DEBUG
__device__ __forceinline__ float bfv(const bf16_t* p) { return __uint_as_float((unsigned)(*p) << 16); }
__device__ __forceinline__ void dbg_flag(int* dbg, int k, float got, float ref) { if (!(fabsf(got - ref) <= 0.03f + 0.03f * fabsf(ref))) atomicAdd(dbg + k, 1); }
#define DBG_SAMPLE_ROW(tid) (((tid) * 97 + 13) % T)
#endif
struct Args { const float* in[27]; float* out; unsigned char* ws; int ph_lo, ph_hi; };
constexpr int NPH = 18;

__global__ void __launch_bounds__(512, 2) mega(Args args) {
    extern __shared__ __attribute__((aligned(16))) unsigned char lds_raw[];
    LAS unsigned char* lds = (LAS unsigned char*)lds_raw;
    cg::grid_group grid = cg::this_grid();
    const int tid = threadIdx.x, lane = tid & 63, wave = __builtin_amdgcn_readfirstlane(tid >> 6);
    const int G = gridDim.x, bx = blockIdx.x; const int vcu = (G % 8 == 0) ? (bx % 8) * (G / 8) + bx / 8 : bx;
    const int gw = vcu * 8 + wave, NGW = G * 8;
    const long gt = (long)vcu * 512 + tid, NGT = (long)G * 512;
    unsigned char* ws = args.ws;
    const float* xp = args.in[0]; const float* xs = args.in[1];
    float* out = args.out;
#define Win_t ((bf16_t*)(ws + WS_WIN))
#define Wq_t ((bf16_t*)(ws + WS_WQ))
#define Wkv_t ((bf16_t*)(ws + WS_WKV))
#define Wgate_t ((bf16_t*)(ws + WS_WGATE))
#define Wout_t ((bf16_t*)(ws + WS_WOUT))
#define Wgu_t ((bf16_t*)(ws + WS_WGU))
#define Wd_t ((bf16_t*)(ws + WS_WD))
#define ROPE ((f32x2*)(ws + WS_ROPE))
#define CST ((float*)(ws + WS_CST))
#define SSQ ((float*)(ws + WS_SSQ))
#define CP ((float*)(ws + WS_CP))
#define CHH ((float*)(ws + WS_CHH))
#define CIN ((float*)(ws + WS_CIN))
#define XN ((bf16_t*)(ws + WS_XN))
#define LAF ((_Float16*)(ws + WS_XN))
#define BF ((_Float16*)(ws + WS_XN + HALFROW))
#define ACT ((bf16_t*)(ws + WS_ACT))
#define X1B ((bf16_t*)out)
#define X2B ((bf16_t*)out + (size_t)T * DM)
#define GRG ((bf16_t*)(ws + WS_GRG))
#define YATT GRG
#define QC ((bf16_t*)(ws + WS_QC))
#define KVC ((bf16_t*)(ws + WS_KVC))
#define KR ((bf16_t*)(ws + WS_KR))
#define XRG ((bf16_t*)(ws + WS_XRG))
#define YRG XRG
#define XC ((bf16_t*)(ws + WS_XC))
#define LAB ((_Float16*)(ws + WS_LAB))
#define BB ((_Float16*)(ws + WS_BB))
#define QB ((bf16_t*)(ws + WS_Q))
#define KVB ((bf16_t*)(ws + WS_KV))
    LAS float* scr = (LAS float*)(lds + wave * 16384);

    { volatile LAS unsigned* MISC = (volatile LAS unsigned*)(lds + 131072 + 320); if (tid < 32) MISC[tid] = 0u; }
    __syncthreads();
    xcd_barrier_post((unsigned*)(ws + WS_BAR));
    const int lo = args.ph_lo, hi = args.ph_hi;
#ifndef PH_MASK
#define PH_MASK 0x3ffff
#endif
#define IN(k) (((PH_MASK >> (k)) & 1) && lo <= (k) && (k) < hi)
#ifndef REP_MASK
#define REP_MASK 0
#endif
#ifndef DUP_MASK
#define DUP_MASK 0
#endif
#define DUPK(k) ((((DUP_MASK) >> (k)) & 1) ? 2 : 1)
#define REPS(k) ((((REP_MASK) >> (k)) & 1) ? 2 : 1)
#define SEAM(k) do { if (IN(k) && IN((k) + 1)) { if (hi < 0) grid.sync(); xcd_barrier((unsigned*)(ws + WS_BAR), (volatile LAS unsigned*)(lds + 131072 + 320) + 8); } } while (0)
#ifdef MK_DEBUG
    int* DBG = (int*)(ws + WS_DBG); float* DSAV = (float*)(ws + WS_DBG + 64);
#endif

    if (IN(0)) for (int rep_ = 0; rep_ < REPS(0); ++rep_) {
        constexpr int I_G = 32 * 176, I_D = 88 * 64, I_IN = 32 * 90, I_Q = 8 * 48, I_KV = 4 * 64, I_O = 32 * 64;
        constexpr int NIT = 2 * I_G + I_D + I_IN + I_Q + I_KV + I_O;
        for (int it = gw; it < NIT; it += NGW) {
            int r = it;
            if (r < I_G) { transpose_item(args.in[3], FF, nullptr, Wgu_t, DM, MapGU{0}, scr, r, lane); continue; } r -= I_G;
            if (r < I_G) { transpose_item(args.in[4], FF, nullptr, Wgu_t, DM, MapGU{128}, scr, r, lane); continue; } r -= I_G;
            if (r < I_D) { transpose_item(args.in[5], DM, nullptr, Wd_t, FF, MapId{}, scr, r, lane); continue; } r -= I_D;
            if (r < I_IN) { transpose_item(args.in[7], 2880, nullptr, Win_t, DM, MapWin{}, scr, r, lane); continue; } r -= I_IN;
            if (r < I_Q) { transpose_item(args.in[16], NQ, args.in[15], Wq_t, QL, MapQ{}, scr, r, lane); continue; } r -= I_Q;
            if (r < I_KV) { transpose_item(args.in[18], NKV, args.in[17], Wkv_t, KVL, MapId{}, scr, r, lane); continue; } r -= I_KV;
            transpose_item(args.in[21], DM, nullptr, Wout_t, DM, MapId{}, scr, r, lane);
        }
        for (long e = gt; e < 4096 * 16; e += NGT) { const int row = (int)(e >> 4), k8 = (int)(e & 15) * 8;
            const int dir = row >> 11, cgi = (row >> 8) & 7, gate = (row >> 7) & 1, cl = row & 127; const int c = cgi * 128 + cl, hb = c >> 6, j = c & 63;
            const float* w = (gate ? args.in[12] : args.in[10]) + ((size_t)(dir * 16 + hb) * 64) * 64;
            float v[8];
#pragma unroll
            for (int q = 0; q < 8; ++q) { const int ci = cgi * 128 + k8 + q; v[q] = ((ci >> 6) == hb) ? w[(ci & 63) * 64 + j] : 0.f; }
            u32x4 o; o.x = cvt_pk_bf16(v[0], v[1]); o.y = cvt_pk_bf16(v[2], v[3]); o.z = cvt_pk_bf16(v[4], v[5]); o.w = cvt_pk_bf16(v[6], v[7]);
            *(u32x4*)(Wgate_t + (size_t)row * 128 + k8) = o; }
#ifdef MK_DEBUG
        if (bx == 0 && tid < 16) DBG[tid] = 0;
#endif
        for (long e = gt; e < 2 * RG; e += NGT) { const float lam = args.in[14][e]; const float sp = (lam < -20.f) ? -lam : log1pf(expf(-lam)); CST[e] = -8.0f * sp * LOG2E; }
        for (long e = gt; e < 8192 * 32; e += NGT) { const int pos = (int)(e >> 5), i = (int)(e & 31);
            const float inv = 1.0f / powf(10000.0f, (float)(2 * i) / 64.0f);
            const float ang = (float)pos * inv;
            const double rev = (double)ang * 0.15915494309189535; const float fr = (float)(rev - rint(rev));
            ROPE[e] = (f32x2){__builtin_amdgcn_cosf(fr), __builtin_amdgcn_sinf(fr)}; }
        for (int m = gw; m < T; m += NGW) rms_row_to_bf16(m < TP ? xp + (size_t)m * DM : xs + (size_t)(m - TP) * DM, args.in[2], XN + (size_t)m * DM, lane);
    }
    SEAM(0);
    if (IN(1)) for (int rep_ = 0; rep_ < REPS(1); ++rep_) { pg8::Gemm g{XN, Wgu_t, DM, DM, DM, T / 256, NGU / 256, 1, 0, 0}; pg8::StaticOrder S; S.init(g.nM, g.nN, G, bx, DUPK(1)); pg8::EpiSwiglu E{ACT}; pg8::gemm_phase(lds, g, S, E); }
    SEAM(1);
    if (IN(2)) for (int rep_ = 0; rep_ < REPS(2); ++rep_) { pg8::Gemm g{ACT, Wd_t, FF, FF, FF, T / 256, DM / 256, 1, 0, 1}; pg8::StaticOrder S; S.init(g.nM, g.nN, G, bx, DUPK(2), 4); pg8::EpiResidBf<false> E{xp, xs, nullptr, X1B, 0.5f}; pg8::gemm_phase(lds, g, S, E); }
    SEAM(2);
    if (IN(3)) for (int rep_ = 0; rep_ < REPS(3); ++rep_) {
        constexpr int I_G = 32 * 176, I_D = 88 * 64, NIT = 2 * I_G + I_D;
        for (int it = gw; it < NIT; it += NGW) {
            int r = it;
            if (r < I_G) { transpose_item(args.in[23], FF, nullptr, Wgu_t, DM, MapGU{0}, scr, r, lane); continue; } r -= I_G;
            if (r < I_G) { transpose_item(args.in[24], FF, nullptr, Wgu_t, DM, MapGU{128}, scr, r, lane); continue; } r -= I_G;
            transpose_item(args.in[25], DM, nullptr, Wd_t, FF, MapId{}, scr, r, lane);
        }
        for (int m = gw; m < T; m += NGW) rms_rowbf_to_bf16(X1B + (size_t)m * DM, args.in[6], XN + (size_t)m * DM, lane);
    }
    SEAM(3);
    if (IN(4)) for (int rep_ = 0; rep_ < REPS(4); ++rep_) { pg8::Gemm g{XN, Win_t, DM, DM, DM, T / 256, DINP / 256, 1, 0, 0}; pg8::StaticOrder S; S.init(g.nM, g.nN, G, bx, DUPK(4)); pg8::EpiWin E{XRG, GRG, QC, KVC, KR, SSQ, ROPE}; pg8::gemm_phase(lds, g, S, E); }
    SEAM(4);
    if (IN(5)) for (int rep_ = 0; rep_ < REPS(5); ++rep_) {
        const float* cw = args.in[8]; const float* cb = args.in[9];
        for (long e = gt; e < (long)T * 128; e += NGT) { const int row = (int)(e >> 7), c0 = (int)(e & 127) * 8; const int pos = row_pos(row), S = row < TP ? 2048 : 8192;
            float a[8];
#pragma unroll
            for (int q = 0; q < 8; ++q) a[q] = cb[c0 + q];
#pragma unroll
            for (int k = 0; k < 4; ++k) { const int p = pos - 2 + k; if (p >= 0 && p < S) { const u32x4 xw = *(const u32x4*)(XRG + (size_t)(row - 2 + k) * RG + c0);
#pragma unroll
                    for (int q = 0; q < 8; ++q) { const unsigned w = xw[q >> 1]; a[q] += cw[k * RG + c0 + q] * ((q & 1) ? bf_hi(w) : bf_lo(w)); } } }
            u32x4 o; o.x = cvt_pk_bf16(a[0], a[1]); o.y = cvt_pk_bf16(a[2], a[3]); o.z = cvt_pk_bf16(a[4], a[5]); o.w = cvt_pk_bf16(a[6], a[7]);
            *(u32x4*)(XC + (size_t)row * RG + c0) = o; }
    }
    SEAM(5);
    if (IN(6)) for (int rep_ = 0; rep_ < REPS(6); ++rep_) { int k128 = 128; asm volatile("" : "+s"(k128)); pg8::Gemm g{XC, Wgate_t, RG, 128, k128, T / 256, 16, 8, 128, 0}; pg8::StaticOrder S; S.init(g.nM, g.nN, G, bx, DUPK(6)); pg8::EpiGates E{XC, LAF, BF, LAB, BB, args.in[11], args.in[13], CST}; pg8::gemm_phase(lds, g, S, E); }
    SEAM(6);
    if (IN(7)) for (int rep_ = 0; rep_ < REPS(7); ++rep_) {
        for (long e = gt; e < (long)2 * NCHUNK * 256; e += NGT) { const int c0 = (int)(e & 255) * 4; const int ch = (int)((e >> 8) % NCHUNK), dir = (int)((e >> 8) / NCHUNK);
            const _Float16* LA = dir ? LAB : LAF; const _Float16* B = dir ? BB : BF;
            float P0 = 1.f, P1 = 1.f, P2 = 1.f, P3 = 1.f, H0 = 0.f, H1 = 0.f, H2 = 0.f, H3 = 0.f;
            const int t0 = ch * CH_L + (dir ? CH_L - 1 : 0); const long tstep = dir ? -(long)RG : (long)RG;
            const _Float16* pl = LA + (size_t)t0 * RG + c0; const _Float16* pb = B + (size_t)t0 * RG + c0;
#pragma unroll 1
            for (int s8 = 0; s8 < CH_L; s8 += 8) {
                h16x4 lv[8], bv[8];
#pragma unroll
                for (int q = 0; q < 8; ++q) { lv[q] = *(const h16x4*)(pl + q * tstep); bv[q] = *(const h16x4*)(pb + q * tstep); }
                pl += 8 * tstep; pb += 8 * tstep;
#pragma unroll
                for (int q = 0; q < 8; ++q) {
                    const float a0 = __builtin_amdgcn_exp2f((float)lv[q][0]), a1 = __builtin_amdgcn_exp2f((float)lv[q][1]), a2 = __builtin_amdgcn_exp2f((float)lv[q][2]), a3 = __builtin_amdgcn_exp2f((float)lv[q][3]);
                    H0 = a0 * H0 + (float)bv[q][0]; H1 = a1 * H1 + (float)bv[q][1]; H2 = a2 * H2 + (float)bv[q][2]; H3 = a3 * H3 + (float)bv[q][3];
                    P0 *= a0; P1 *= a1; P2 *= a2; P3 *= a3; } }
            const size_t o = ((size_t)dir * NCHUNK + ch) * RG + c0;
            *(f32x4*)(CP + o) = (f32x4){P0, P1, P2, P3}; *(f32x4*)(CHH + o) = (f32x4){H0, H1, H2, H3}; }
    }
    SEAM(7);
    if (IN(8)) for (int rep_ = 0; rep_ < REPS(8); ++rep_) {
        for (long e = gt; e < (long)9 * 2 * RG; e += NGT) { const int c = (int)(e & (RG - 1)); const int dir = (int)((e >> 10) & 1), sq = (int)(e >> 11);
            const int ch0 = sq < 8 ? sq * 64 : 512, nch = sq < 8 ? 64 : 256;
            float hcar = 0.f;
#pragma unroll 8
            for (int s = 0; s < nch; ++s) { const int ch = ch0 + (dir ? (nch - 1 - s) : s); const size_t o = ((size_t)dir * NCHUNK + ch) * RG + c;
                CIN[o] = hcar; hcar = CP[o] * hcar + CHH[o]; }
        }
    }
    SEAM(8);
    if (IN(9)) for (int rep_ = 0; rep_ < REPS(9); ++rep_) {
        for (long e = gt; e < (long)NCHUNK * 512; e += NGT) { const int c0 = (int)(e & 511) * 2; const int ch = (int)(e >> 9);
            float hf[CH_L][2];
            const char* pLAF = (const char*)LAF; const char* pBF = (const char*)BF; const char* pLAB = (const char*)LAB; const char* pBB = (const char*)BB; const char* pG = (const char*)GRG; char* pY = (char*)YRG;
            unsigned off = (unsigned)((ch * CH_L) * RG + c0) * 2u;
            { float h0 = CIN[(size_t)ch * RG + c0], h1 = CIN[(size_t)ch * RG + c0 + 1];
#pragma unroll
              for (int s = 0; s < CH_L; ++s) {
                  const h16x2 l = __builtin_bit_cast(h16x2, *(const unsigned*)(pLAF + off)), b = __builtin_bit_cast(h16x2, *(const unsigned*)(pBF + off));
                  h0 = __builtin_amdgcn_exp2f((float)l[0]) * h0 + (float)b[0]; h1 = __builtin_amdgcn_exp2f((float)l[1]) * h1 + (float)b[1]; hf[s][0] = h0; hf[s][1] = h1;
                  if (s + 1 < CH_L) { off += RG * 2; asm volatile("" : "+v"(off)); } } }
            { float h0 = CIN[((size_t)NCHUNK + ch) * RG + c0], h1 = CIN[((size_t)NCHUNK + ch) * RG + c0 + 1];
#pragma unroll
              for (int s = CH_L - 1; s >= 0; --s) {
                  const h16x2 l = __builtin_bit_cast(h16x2, *(const unsigned*)(pLAB + off)), b = __builtin_bit_cast(h16x2, *(const unsigned*)(pBB + off));
                  h0 = __builtin_amdgcn_exp2f((float)l[0]) * h0 + (float)b[0]; h1 = __builtin_amdgcn_exp2f((float)l[1]) * h1 + (float)b[1];
                  const unsigned gwd = *(const unsigned*)(pG + off);
                  const float y0 = (hf[s][0] + h0) * gelu_tanh(bf_lo(gwd)), y1 = (hf[s][1] + h1) * gelu_tanh(bf_hi(gwd));
                  *(unsigned*)(pY + off) = cvt_pk_bf16(y0, y1);
                  if (s > 0) { off -= RG * 2; asm volatile("" : "+v"(off)); } } }
        }
    }
    SEAM(9);
    if (IN(10)) for (int rep_ = 0; rep_ < REPS(10); ++rep_) {
        { pg8::Gemm g{QC, Wq_t, QL, QL, QL, T / 256, NQ / 256, 1, 0, 0}; pg8::StaticOrder S; S.init(g.nM, g.nN, G, bx, DUPK(10)); pg8::EpiQ E{QB, SSQ, ROPE}; pg8::gemm_phase(lds, g, S, E); }
        { pg8::Gemm g{KVC, Wkv_t, KVL, KVL, KVL, T / 256, NKV / 256, 1, 0, 0}; pg8::StaticOrder S; S.init(g.nM, g.nN, G, bx, DUPK(10)); pg8::EpiKV E{KVB, SSQ}; pg8::gemm_phase(lds, g, S, E); }
    }
    SEAM(10);
    if (IN(11)) for (int rep_ = 0; rep_ < REPS(11); ++rep_) {
        for (int u = vcu; u < 256; u += G) att::attn_unit(lds, QB, KVB, KR, YATT, TP + (u & 31) * 256, TP, 8192, u >> 5);
        for (int p = vcu; p < 256; p += G)
            for (int k = 0; k < 2; ++k) { const int u = 2 * p + k; const int sh = u >> 3, qb = u & 7, sq = sh >> 3, h = sh & 7;
                att::attn_unit(lds, QB, KVB, KR, YATT, sq * 2048 + qb * 256, sq * 2048, 2048, h); }
    }
    SEAM(11);
    if (IN(12)) for (int rep_ = 0; rep_ < REPS(12); ++rep_) {
        const float* g1 = args.in[19]; const float* g2 = args.in[20];
        for (int m = gw; m < T; m += NGW) {
#pragma unroll
            for (int half = 0; half < 2; ++half) { const bf16_t* src = (half ? YATT : YRG) + (size_t)m * RG + lane * 16; const float* gg = (half ? g2 : g1) + lane * 16;
                const u32x4 w0 = *(const u32x4*)src, w1 = *(const u32x4*)(src + 8); float v[16];
#pragma unroll
                for (int q = 0; q < 4; ++q) { v[2 * q] = bf_lo(w0[q]); v[2 * q + 1] = bf_hi(w0[q]); v[8 + 2 * q] = bf_lo(w1[q]); v[8 + 2 * q + 1] = bf_hi(w1[q]); }
                float s = 0.f;
#pragma unroll
                for (int q = 0; q < 16; ++q) s += v[q] * v[q];
                const float rstd = __builtin_amdgcn_rsqf(wave_sum(s) * (1.f / RG) + EPS);
                u32x4 o0, o1;
#pragma unroll
                for (int q = 0; q < 4; ++q) { o0[q] = cvt_pk_bf16(v[2 * q] * rstd * gg[2 * q], v[2 * q + 1] * rstd * gg[2 * q + 1]); o1[q] = cvt_pk_bf16(v[8 + 2 * q] * rstd * gg[8 + 2 * q], v[8 + 2 * q + 1] * rstd * gg[8 + 2 * q + 1]); }
                bf16_t* dst = XN + (size_t)m * DM + half * RG + lane * 16; *(u32x4*)dst = o0; *(u32x4*)(dst + 8) = o1; }
        }
    }
    SEAM(12);
    if (IN(13)) for (int rep_ = 0; rep_ < REPS(13); ++rep_) { pg8::Gemm g{XN, Wout_t, DM, DM, DM, T / 256, DM / 256, 1, 0, 0}; pg8::StaticOrder S; S.init(g.nM, g.nN, G, bx, DUPK(13), 4); pg8::EpiResidBf<true> E{nullptr, nullptr, X1B, X2B, 1.0f}; pg8::gemm_phase(lds, g, S, E); }
    SEAM(13);
    if (IN(14)) for (int rep_ = 0; rep_ < REPS(14); ++rep_) { for (int m = gw; m < T; m += NGW) rms_rowbf_to_bf16(X2B + (size_t)m * DM, args.in[22], XN + (size_t)m * DM, lane); }
    SEAM(14);
    if (IN(15)) for (int rep_ = 0; rep_ < REPS(15); ++rep_) { pg8::Gemm g{XN, Wgu_t, DM, DM, DM, T / 256, NGU / 256, 1, 0, 0}; pg8::StaticOrder S; S.init(g.nM, g.nN, G, bx, DUPK(15)); pg8::EpiSwiglu E{ACT}; pg8::gemm_phase(lds, g, S, E); }
    SEAM(15);
    if (IN(16)) for (int rep_ = 0; rep_ < REPS(16); ++rep_) { pg8::Gemm g{ACT, Wd_t, FF, FF, FF, T / 256, DM / 256, 1, 0, 1}; pg8::StaticOrder S; S.init(g.nM, g.nN, G, bx, DUPK(16), 4); pg8::EpiResidBf<true> E{nullptr, nullptr, X2B, XN, 0.5f}; pg8::gemm_phase(lds, g, S, E); }
    SEAM(16);
    if (IN(17)) for (int rep_ = 0; rep_ < REPS(17); ++rep_) {
        const float* g = args.in[26];
        float dscale = 1.f;
#ifdef MK_DEBUG
        { int kf = 0; for (int k = 15; k >= 1; --k) if (DBG[k] > 0) kf = k; dscale = 1.f + 0.5f * kf; }
#endif
        for (int m = gw; m < T; m += NGW) { const u32x4* xr = (const u32x4*)(XN + (size_t)m * DM) + lane;
            float v[4][8]; float s = 0.f;
#pragma unroll
            for (int j = 0; j < 4; ++j) { const u32x4 w = xr[64 * j];
#pragma unroll
                for (int q = 0; q < 4; ++q) { v[j][2 * q] = bf_lo(w[q]); v[j][2 * q + 1] = bf_hi(w[q]); s += v[j][2 * q] * v[j][2 * q] + v[j][2 * q + 1] * v[j][2 * q + 1]; } }
            const float rstd = __builtin_amdgcn_rsqf(wave_sum(s) * (1.f / DM) + EPS) * dscale;
            float* orow = out + (size_t)m * DM;
#pragma unroll
            for (int j = 0; j < 4; ++j) { const int c = 8 * (lane + 64 * j); const f32x4 g0 = *(const f32x4*)(g + c), g1 = *(const f32x4*)(g + c + 4);
                *(f32x4*)(orow + c) = (f32x4){v[j][0] * rstd * g0[0], v[j][1] * rstd * g0[1], v[j][2] * rstd * g0[2], v[j][3] * rstd * g0[3]};
                *(f32x4*)(orow + c + 4) = (f32x4){v[j][4] * rstd * g1[0], v[j][5] * rstd * g1[1], v[j][6] * rstd * g1[2], v[j][7] * rstd * g1[3]}; } }
    }
#undef IN
#undef SEAM
}

#ifdef MK_DEBUG
__global__ void __launch_bounds__(512) dbg_check(Args args, int seam) {
    unsigned char* ws = args.ws; const float* xp = args.in[0]; const float* xs = args.in[1]; float* out = args.out; const int tid = threadIdx.x;
    int* DBG = (int*)(ws + WS_DBG); float* DSAV = (float*)(ws + WS_DBG + 64); const int row = DBG_SAMPLE_ROW(tid);
    if (seam == 1) { const int f = (tid * 53 + 7) % FF; float g = 0.f, u = 0.f; for (int k = 0; k < DM; ++k) { const float a = bfv(XN + (size_t)row * DM + k); g += a * args.in[3][(size_t)k * FF + f]; u += a * args.in[4][(size_t)k * FF + f]; }
        dbg_flag(DBG, 1, bfv(ACT + (size_t)row * FF + f), g * sigmoidf_(g) * u); }
    if (seam == 2) { const int c = (tid * 29 + 3) % DM; float a = 0.f; for (int f = 0; f < FF; ++f) a += bfv(ACT + (size_t)row * FF + f) * args.in[5][(size_t)f * DM + c];
        const float xv = row < TP ? xp[(size_t)row * DM + c] : xs[(size_t)(row - TP) * DM + c]; dbg_flag(DBG, 2, out[(size_t)row * DM + c], xv + 0.5f * a); }
    if (seam == 4) { const int n = (tid * 37 + 5) % 2880;
        if (n < 2816) { float z = 0.f; for (int k = 0; k < DM; ++k) z += bfv(XN + (size_t)row * DM + k) * args.in[7][(size_t)k * 2880 + n];
            const float got = n < 1024 ? bfv(XRG + (size_t)row * RG + n) : n < 2048 ? bfv(GRG + (size_t)row * RG + n - 1024) : n < 2560 ? bfv(QC + (size_t)row * QL + n - 2048) : bfv(KVC + (size_t)row * KVL + n - 2560);
            dbg_flag(DBG, 3, got, z); }
        else { const int i = (n - 2816) & 31; float x1 = 0.f, x2 = 0.f; for (int k = 0; k < DM; ++k) { const float a = bfv(XN + (size_t)row * DM + k); x1 += a * args.in[7][(size_t)k * 2880 + 2816 + i]; x2 += a * args.in[7][(size_t)k * 2880 + 2848 + i]; }
            const float ang = (float)row_pos(row) * (1.0f / powf(10000.0f, (float)(2 * i) / 64.0f)); const float c = cosf(ang), sn = sinf(ang);
            dbg_flag(DBG, 4, bfv(KR + (size_t)row * 64 + i), x1 * c - x2 * sn); dbg_flag(DBG, 4, bfv(KR + (size_t)row * 64 + 32 + i), x2 * c + x1 * sn); } }
    if (seam == 5) { const int c = (tid * 29 + 3) % RG; const int pos = row_pos(row), S = row < TP ? 2048 : 8192; float a = args.in[9][c];
        for (int k = 0; k < 4; ++k) { const int p = pos - 2 + k; if (p >= 0 && p < S) a += args.in[8][k * RG + c] * bfv(XRG + (size_t)(row - 2 + k) * RG + c); }
        dbg_flag(DBG, 5, bfv(XC + (size_t)row * RG + c), a); }
    if (seam == 6) { const int c = (tid * 29 + 3) % RG; const int dir = tid & 1, hb = c >> 6, j = c & 63; float pa = args.in[11][dir * RG + c], px = args.in[13][dir * RG + c];
        for (int i = 0; i < 64; ++i) { const float xv = bfv(XC + (size_t)row * RG + hb * 64 + i); pa += xv * args.in[10][((size_t)(dir * 16 + hb) * 64 + i) * 64 + j]; px += xv * args.in[12][((size_t)(dir * 16 + hb) * 64 + i) * 64 + j]; }
        const float lam = args.in[14][dir * RG + c]; const float r = 1.f / (1.f + expf(-pa)), ig = 1.f / (1.f + expf(-px)); const float loga = -8.f * r * log1pf(expf(-lam));
        const float bref = sqrtf(-expm1f(2.f * loga)) * ig * bfv(XC + (size_t)row * RG + c);
        const _Float16* LA = dir ? LAB : LAF; const _Float16* Bp = dir ? BB : BF;
        if (!(fabsf((float)LA[(size_t)row * RG + c] - loga * LOG2E) <= 1e-4f + 0.02f * fabsf(loga * LOG2E))) atomicAdd(DBG + 6, 1);
        if (!(fabsf((float)Bp[(size_t)row * RG + c] - bref) <= 2e-3f + 0.03f * fabsf(bref))) atomicAdd(DBG + 7, 1); }
    if (seam == 9) { { const int c = (tid * 29 + 3) % RG; const int dir = tid & 1; const int ch = (tid * 7 + 1) % NCHUNK; const _Float16* LA = dir ? LAB : LAF; const _Float16* Bp = dir ? BB : BF;
            float P = 1.f, H = 0.f; for (int s2 = 0; s2 < CH_L; ++s2) { const int t = ch * CH_L + (dir ? CH_L - 1 - s2 : s2); const float a = exp2f((float)LA[(size_t)t * RG + c]); H = a * H + (float)Bp[(size_t)t * RG + c]; P *= a; }
            const size_t o = ((size_t)dir * NCHUNK + ch) * RG + c;
            if (!(fabsf(CP[o] - P) <= 1e-3f + 0.01f * fabsf(P))) atomicAdd(DBG + 1, 1);
            if (!(fabsf(CHH[o] - H) <= 1e-3f + 0.01f * fabsf(H))) atomicAdd(DBG + 2, 1);
            const int ch0 = ch < 512 ? (ch & ~63) : 512, nch = ch < 512 ? 64 : 256; float hc = 0.f;
            if (dir == 0) { for (int q = ch0; q < ch; ++q) { const size_t oo = ((size_t)0 * NCHUNK + q) * RG + c; hc = CP[oo] * hc + CHH[oo]; } }
            else { for (int q = ch0 + nch - 1; q > ch; --q) { const size_t oo = ((size_t)1 * NCHUNK + q) * RG + c; hc = CP[oo] * hc + CHH[oo]; } }
            if (!(fabsf(CIN[o] - hc) <= 1e-3f + 0.01f * fabsf(hc))) atomicAdd(DBG + 3, 1); }
 const int c = (tid * 29 + 3) % RG; const int s0 = row < TP ? (row & ~2047) : TP, S = row < TP ? 2048 : 8192; float hf = 0.f, hb = 0.f;
        for (int t = s0; t <= row; ++t) hf = exp2f((float)LAF[(size_t)t * RG + c]) * hf + (float)BF[(size_t)t * RG + c];
        for (int t = s0 + S - 1; t >= row; --t) hb = exp2f((float)LAB[(size_t)t * RG + c]) * hb + (float)BB[(size_t)t * RG + c];
        const float g = bfv(GRG + (size_t)row * RG + c); const float ge = 0.5f * g * (1.f + tanhf(0.7978845608f * (g + 0.044715f * g * g * g)));
        dbg_flag(DBG, 8, bfv(YRG + (size_t)row * RG + c), (hf + hb) * ge); }
    if (seam == 10) { { const int n = (tid * 37 + 5) % NQ; const int h = n / 192, d = n % 192; float ss = 0.f; for (int k = 0; k < QL; ++k) { const float a = bfv(QC + (size_t)row * QL + k); ss += a * a; }
          const float rstd = 1.f / sqrtf(ss / QL + EPS); float ref;
          if (d < 128) { float q = 0.f; for (int k = 0; k < QL; ++k) q += bfv(QC + (size_t)row * QL + k) * args.in[15][k] * args.in[16][(size_t)k * NQ + n]; ref = q * rstd; }
          else { const int i = (d - 128) & 31; float x1 = 0.f, x2 = 0.f; for (int k = 0; k < QL; ++k) { const float a = bfv(QC + (size_t)row * QL + k) * args.in[15][k]; x1 += a * args.in[16][(size_t)k * NQ + h * 192 + 128 + i]; x2 += a * args.in[16][(size_t)k * NQ + h * 192 + 160 + i]; }
            x1 *= rstd; x2 *= rstd; const float ang = (float)row_pos(row) * (1.0f / powf(10000.0f, (float)(2 * i) / 64.0f)); const float c = cosf(ang), sn = sinf(ang); ref = (d < 160) ? x1 * c - x2 * sn : x2 * c + x1 * sn; }
          dbg_flag(DBG, 9, bfv(QB + (size_t)row * NQ + n), ref); }
        { const int n = (tid * 41 + 11) % NKV; float ss = 0.f, q = 0.f; for (int k = 0; k < KVL; ++k) { const float a = bfv(KVC + (size_t)row * KVL + k); ss += a * a; q += a * args.in[17][k] * args.in[18][(size_t)k * NKV + n]; }
          dbg_flag(DBG, 10, bfv(KVB + (size_t)row * NKV + n), q / sqrtf(ss / KVL + EPS)); } }
    if (seam == 11) { const int h = tid & 7, d = (tid * 13 + 1) & 127; const int s0 = row < TP ? (row & ~2047) : TP, S = row < TP ? 2048 : 8192; float m = -1e30f, l = 0.f, o = 0.f;
        for (int t = s0; t < s0 + S; ++t) { float sc = 0.f; for (int k = 0; k < 128; ++k) sc += bfv(QB + (size_t)row * NQ + h * 192 + k) * bfv(KVB + (size_t)t * NKV + h * 256 + k);
            for (int k = 0; k < 64; ++k) sc += bfv(QB + (size_t)row * NQ + h * 192 + 128 + k) * bfv(KR + (size_t)t * 64 + k);
            sc *= 0.07216878364870322f; const float mn = fmaxf(m, sc); const float al = expf(m - mn), p = expf(sc - mn); l = l * al + p; o = o * al + p * bfv(KVB + (size_t)t * NKV + h * 256 + 128 + d); m = mn; }
        dbg_flag(DBG, 11, bfv(YATT + (size_t)row * RG + h * 128 + d), o / l); }
    if (seam == 12) { const int c = (tid * 29 + 3) % DM; const bf16_t* src = (c < RG ? YRG : YATT) + (size_t)row * RG; float ss = 0.f; for (int k = 0; k < RG; ++k) { const float a = bfv(src + k); ss += a * a; }
        dbg_flag(DBG, 12, bfv(XN + (size_t)row * DM + c), bfv(src + (c & (RG - 1))) / sqrtf(ss / RG + EPS) * (c < RG ? args.in[19][c] : args.in[20][c - RG])); DSAV[tid] = out[(size_t)row * DM + c]; }
    if (seam == 13) { const int c = (tid * 29 + 3) % DM; float a = 0.f; for (int k = 0; k < DM; ++k) a += bfv(XN + (size_t)row * DM + k) * args.in[21][(size_t)k * DM + c];
        dbg_flag(DBG, 13, out[(size_t)row * DM + c], DSAV[tid] + a); }
    if (seam == 15) { const int f = (tid * 53 + 7) % FF; float g = 0.f, u = 0.f; for (int k = 0; k < DM; ++k) { const float a = bfv(XN + (size_t)row * DM + k); g += a * args.in[23][(size_t)k * FF + f]; u += a * args.in[24][(size_t)k * FF + f]; }
        dbg_flag(DBG, 14, bfv(ACT + (size_t)row * FF + f), g * sigmoidf_(g) * u); }
}
#endif
#ifndef MK_PER_PHASE
#define MK_PER_PHASE 0
#endif
extern "C" void kernel_launch(void* const* d_in, const int* in_sizes, int n_in, void* d_out, int out_size, void* d_ws, size_t ws_size, hipStream_t stream) {
    static int grid = 0;
    if (grid == 0) {
        if (n_in != 27 || out_size != T * DM || ws_size < WS_BAR + BAR_BYTES) { fprintf(stderr, "kernel_launch: unexpected shapes: n_in %d out %d ws %zu (need %zu)\n", n_in, out_size, ws_size, (size_t)WS_END); grid = -1; return; }
        int dev = 0, cus = 0, per_cu = 0;
        hipGetDevice(&dev); hipDeviceGetAttribute(&cus, hipDeviceAttributeMultiprocessorCount, dev);
        if (hipFuncSetAttribute((const void*)mega, hipFuncAttributeMaxDynamicSharedMemorySize, LDS_BYTES) != hipSuccess) { fprintf(stderr, "kernel_launch: hipFuncSetAttribute failed\n"); grid = -1; return; }
        if (hipOccupancyMaxActiveBlocksPerMultiprocessor(&per_cu, (const void*)mega, 512, LDS_BYTES) != hipSuccess || per_cu < 1) { fprintf(stderr, "kernel_launch: occupancy query says %d\n", per_cu); per_cu = 1; }
        (void)hipGetLastError();
        grid = cus * per_cu;
    }
    if (grid < 0) return;
    if (hipMemsetAsync((char*)d_ws + WS_BAR, 0, BAR_BYTES, stream) != hipSuccess) { fprintf(stderr, "kernel_launch: memset failed\n"); return; }
    Args a{};
    for (int i = 0; i < 27; ++i) a.in[i] = (const float*)d_in[i];
    a.out = (float*)d_out; a.ws = (unsigned char*)d_ws;
#if MK_PER_PHASE
    for (int p = 0; p < NPH; ++p) { a.ph_lo = p; a.ph_hi = p + 1; hipLaunchKernelGGL(mega, dim3(grid), dim3(512), LDS_BYTES, stream, a);
#ifdef MK_DEBUG
        a.ph_lo = 0; a.ph_hi = NPH; hipLaunchKernelGGL(dbg_check, dim3(1), dim3(512), 0, stream, a, p);
#endif
    }
#else
    a.ph_lo = 0; a.ph_hi = NPH;
    void* kargs[] = {&a};
    hipError_t e = hipLaunchCooperativeKernel((const void*)mega, dim3(grid), dim3(512), kargs, LDS_BYTES, stream);
    if (e != hipSuccess) fprintf(stderr, "kernel_launch: cooperative launch failed: %s (grid %d)\n", hipGetErrorString(e), grid);
#endif
}
```

```cpp
#include <hip/hip_runtime.h>
#include <hip/hip_cooperative_groups.h>
#include <cstdio>
#include <cstdint>
namespace cg = cooperative_groups;

#define LAS __attribute__((address_space(3)))
typedef unsigned short bf16_t;
typedef short bf16x8 __attribute__((ext_vector_type(8)));
typedef short s16x4 __attribute__((ext_vector_type(4)));
typedef float f32x2 __attribute__((ext_vector_type(2)));
typedef float f32x4 __attribute__((ext_vector_type(4)));
typedef float f32x16 __attribute__((ext_vector_type(16)));
typedef unsigned u32x2 __attribute__((ext_vector_type(2)));
typedef unsigned u32x4 __attribute__((ext_vector_type(4)));
typedef _Float16 h16x2 __attribute__((ext_vector_type(2)));
typedef _Float16 h16x8 __attribute__((ext_vector_type(8)));
typedef _Float16 h16x4 __attribute__((ext_vector_type(4)));

constexpr int T = 24576, TP = 16384;
constexpr int DM = 2048, FF = 5632, NGU = 2 * FF, RG = 1024, QL = 512, KVL = 256, NQ = 1536, NKV = 2048, DINP = 3072;
constexpr float EPS = 1e-6f;
constexpr float LOG2E = 1.4426950408889634f;
constexpr int CH_L = 32, NCHUNK = T / CH_L;

constexpr size_t WS_WIN = 0;
constexpr size_t WS_WQ = WS_WIN + (size_t)DINP * DM * 2;
constexpr size_t WS_WKV = WS_WQ + (size_t)NQ * QL * 2;
constexpr size_t WS_WGATE = WS_WKV + (size_t)NKV * KVL * 2;
constexpr size_t WS_WOUT = WS_WGATE + (size_t)4096 * 128 * 2;
constexpr size_t WS_WGU = WS_WOUT + (size_t)DM * DM * 2;
constexpr size_t WS_WD = WS_WGU + (size_t)NGU * DM * 2;
constexpr size_t WS_ROPE = WS_WD + (size_t)DM * FF * 2;
constexpr size_t WS_CST = WS_ROPE + (size_t)8192 * 32 * 8;
constexpr size_t WS_SSQ = WS_CST + (size_t)2 * RG * 4;
constexpr size_t WS_CP = WS_SSQ + (size_t)T * 12 * 4;
constexpr size_t WS_CHH = WS_CP + (size_t)2 * NCHUNK * RG * 4;
constexpr size_t WS_CIN = WS_CHH + (size_t)2 * NCHUNK * RG * 4;
constexpr size_t WS_XN = WS_CIN + (size_t)2 * NCHUNK * RG * 4;
constexpr size_t WS_ACT = WS_XN + (size_t)T * DM * 2;
constexpr size_t HALFROW = (size_t)T * RG * 2;
constexpr size_t WS_GRG = WS_ACT;
constexpr size_t WS_QC = WS_GRG + HALFROW;
constexpr size_t WS_KVC = WS_QC + (size_t)T * QL * 2;
constexpr size_t WS_KR = WS_KVC + (size_t)T * KVL * 2;
constexpr size_t WS_XRG = WS_KR + (size_t)T * 64 * 2;
constexpr size_t WS_XC = WS_XRG + HALFROW;
constexpr size_t WS_LAB = WS_XC + HALFROW;
constexpr size_t WS_BB = WS_LAB + HALFROW;
constexpr size_t WS_Q = WS_XC;
constexpr size_t WS_KV = WS_Q + (size_t)T * NQ * 2;
constexpr size_t WS_END = WS_KV + (size_t)T * NKV * 2;
static_assert(WS_BB + HALFROW <= WS_END, "ws map");
static_assert(WS_XN % 256 == 0 && WS_ACT % 256 == 0 && WS_KR % 256 == 0 && WS_Q % 256 == 0 && WS_KV % 256 == 0, "ws align");

constexpr size_t WS_DBG = WS_END;
constexpr size_t WS_BAR = WS_END + 4096, BAR_BYTES = 16384;
constexpr size_t WS_IRS = WS_BAR + BAR_BYTES, WS_IG = WS_IRS + (size_t)T * 4, WS_TOP = WS_IG + (size_t)DM * 4;
constexpr int LDS_BYTES = 147456;

__device__ __forceinline__ unsigned cvt_pk_bf16(float lo, float hi) { unsigned r; asm volatile("v_cvt_pk_bf16_f32 %0, %1, %2" : "=v"(r) : "v"(lo), "v"(hi)); return r; }
__device__ __forceinline__ float bf_lo(unsigned w) { return __uint_as_float(w << 16); }
__device__ __forceinline__ float bf_hi(unsigned w) { return __uint_as_float(w & 0xffff0000u); }
__device__ __forceinline__ float sigmoidf_(float v) { return __builtin_amdgcn_rcpf(1.0f + __builtin_amdgcn_exp2f(-v * LOG2E)); }
__device__ __forceinline__ float wave_sum(float v) {
#pragma unroll
    for (int o = 1; o < 64; o <<= 1) v += __shfl_xor(v, o);
    return v;
}
__device__ __forceinline__ int row_pos(int row) { return row < TP ? (row & 2047) : (row - TP); }

namespace pg8 {
constexpr int BM = 256, BK = 64, HALF = 128, HTB = HALF * BK * 2, STAGE_BYTES = 8 * HTB, NXCD = 8, WGM = 8;
__device__ __forceinline__ int lds_byte(int r, int c) { const int st = (r >> 4) * 2 + (c >> 5), rr = r & 15, cc = c & 31, ob = rr * 64 + cc * 2; return st * 1024 + (ob ^ (((ob >> 9) & 1) << 5)); }
__device__ __forceinline__ void stage_rc(int b, int& R, int& C) { const int st = b / 1024, sb = b % 1024, swz = sb ^ (((sb >> 9) & 1) << 5); R = (st >> 1) * 16 + swz / 64; C = (st & 1) * 32 + (swz % 64) / 2; }
__device__ __forceinline__ int perm32(int rho) { const int n = rho >> 4, i = rho & 15; return 8 * (i >> 2) + 4 * n + (i & 3); }

struct Unit { int pm, pn; };
struct Gemm { const bf16_t* A; const bf16_t* Bt; int lda, ldb, K, nM, nN, amod, astep, ablk; };

struct StaticOrder {
    int nM, nN, nwg, G, c, tot, wgm;
    __device__ void init(int nM_, int nN_, int G_, int c_, int dup = 1, int wgm_ = WGM) { nM = nM_; nN = nN_; nwg = nM * nN; G = G_; c = c_; tot = nwg * dup; wgm = wgm_; }
    __device__ bool next(int i, Unit& u) const {
        const long L = (long)i * G + c; if (L >= tot) return false;
        int wgid = (int)(L % nwg); { const int q = nwg / NXCD, r = nwg % NXCD, xcd = wgid % NXCD, off = wgid / NXCD; wgid = (xcd < r ? xcd * (q + 1) : r * (q + 1) + (xcd - r) * q) + off; }
        const int nig = wgm * nN, gid = wgid / nig, fm = gid * wgm, gsz = (nM - fm) < wgm ? (nM - fm) : wgm;
        u.pm = fm + ((wgid % nig) % gsz); u.pn = (wgid % nig) / gsz; return true;
    }
};

template <class Epi>
__device__ __forceinline__ void gemm_phase(LAS unsigned char* lds, const Gemm g, const StaticOrder& S, const Epi& E) {
    const int tid = threadIdx.x, wid = __builtin_amdgcn_readfirstlane(tid >> 6), lane = tid & 63, wr = wid >> 2, wc = wid & 3, fr = lane & 15, fq = lane >> 4;
    const int K = g.K, nt = K / BK;
    unsigned voffA[2], voffB[2];
#pragma unroll
    for (int i = 0; i < 2; ++i) { int R, C; stage_rc(tid * 16 + i * 8192, R, C); const int Rb = Epi::PERM ? ((R & ~31) + perm32(R & 31)) : R;
        voffA[i] = g.ablk ? (unsigned)(tid * 16 + i * 8192) : (unsigned)(R * g.lda + C) * 2u; voffB[i] = (unsigned)(Rb * g.ldb + C) * 2u; }
    const size_t kstep = (size_t)(BK * 2), kstepA = g.ablk ? (size_t)HTB : kstep;
    const size_t hstepA = g.ablk ? (size_t)(K / BK) * HTB : (size_t)HALF * g.lda * 2, hstepB = (size_t)HALF * g.ldb * 2;
    const size_t tstepA = 2 * hstepA, tstepB = 2 * hstepB;
    const unsigned ldsw = (unsigned)wid * 1024u;
    const int aoff = lds_byte(wr * 64 + fr, fq * 8), boff = lds_byte(wc * 32 + fr, fq * 8);
#define PG8_SA(b, h) (((b) * 2 + (h)) * HTB)
#define PG8_SB(b, h) ((4 + (b) * 2 + (h)) * HTB)
#define PG8_STAGE(bufoff, gbase, voff) do { _Pragma("unroll") for (int _i = 0; _i < 2; ++_i) \
        __builtin_amdgcn_global_load_lds((const unsigned*)((const char*)(gbase) + (voff)[_i]), (LAS unsigned*)(lds + (bufoff) + ldsw + _i * 8192), 16, 0, 0); } while (0)
#define PG8_LDA(dst, b, h) do { _Pragma("unroll") for (int m = 0; m < 4; ++m) _Pragma("unroll") for (int k = 0; k < 2; ++k) dst[m][k] = *(const LAS bf16x8*)(lds + PG8_SA(b, h) + aoff + m * 2048 + k * 1024); } while (0)
#define PG8_LDB(dst, b, h) do { _Pragma("unroll") for (int n = 0; n < 2; ++n) _Pragma("unroll") for (int k = 0; k < 2; ++k) dst[n][k] = *(const LAS bf16x8*)(lds + PG8_SB(b, h) + boff + n * 2048 + k * 1024); } while (0)
#define PG8_MMA(ai, bj, At, Bt) do { __builtin_amdgcn_s_setprio(1); _Pragma("unroll") for (int m = 0; m < 4; ++m) _Pragma("unroll") for (int n = 0; n < 2; ++n) _Pragma("unroll") for (int k = 0; k < 2; ++k) \
        acc[ai][bj][m][n] = __builtin_amdgcn_mfma_f32_16x16x32_bf16(Bt[n][k], At[m][k], acc[ai][bj][m][n], 0, 0, 0); __builtin_amdgcn_s_setprio(0); } while (0)
#define PG8_WAIT_V(n) asm volatile("s_waitcnt vmcnt(" #n ")" ::: "memory")
#define PG8_WAIT_L(n) asm volatile("s_waitcnt lgkmcnt(" #n ")" ::: "memory")
#define PG8_BAR __builtin_amdgcn_s_barrier()
#define PG8_SCHED __builtin_amdgcn_sched_barrier(0)
#define PG8_APTR(u) ((const char*)g.A + (size_t)(u).pm * tstepA + (size_t)(((u).pn % g.amod) * g.astep) * 2)
#define PG8_BPTR(u) ((const char*)g.Bt + (size_t)(u).pn * tstepB)
    Unit cur, nxt; int ui = 0;
    if (!S.next(0, cur)) return;
    f32x4 acc[2][2][4][2];
#pragma unroll
    for (int a = 0; a < 2; ++a)
#pragma unroll
        for (int b = 0; b < 2; ++b)
#pragma unroll
            for (int m = 0; m < 4; ++m)
#pragma unroll
                for (int n = 0; n < 2; ++n) acc[a][b][m][n] = (f32x4){0.f, 0.f, 0.f, 0.f};
    bf16x8 At[4][2], B0[2][2], B1[2][2];
    const char* cA = PG8_APTR(cur); const char* cB = PG8_BPTR(cur);
    PG8_STAGE(PG8_SB(0, 0), cB, voffB); PG8_STAGE(PG8_SB(0, 1), cB + hstepB, voffB); PG8_STAGE(PG8_SA(0, 0), cA, voffA); PG8_STAGE(PG8_SA(0, 1), cA + hstepA, voffA);
    if (wr == 1) PG8_BAR;
    PG8_WAIT_V(2); PG8_BAR;
    PG8_STAGE(PG8_SB(1, 0), cB + kstep, voffB); PG8_STAGE(PG8_SA(1, 0), cA + kstepA, voffA); PG8_STAGE(PG8_SB(1, 1), cB + hstepB + kstep, voffB);
    PG8_WAIT_V(6); PG8_BAR;
    for (;;) {
        const bool has_next = S.next(ui + 1, nxt);
        const char* nA = has_next ? PG8_APTR(nxt) : cA; const char* nB = has_next ? PG8_BPTR(nxt) : cB;
        for (int t = 0; t < nt; t += 2) {
            const bool last = (t == nt - 2);
            const char* a1 = cA + (size_t)(t + 1) * kstepA;
            const char* a2 = last ? nA : cA + (size_t)(t + 2) * kstepA; const char* b2 = last ? nB : cB + (size_t)(t + 2) * kstep;
            const char* a3 = a2 + kstepA; const char* b3 = b2 + kstep;
            PG8_LDB(B0, 0, 0); PG8_LDB(B1, 0, 1); PG8_SCHED; PG8_LDA(At, 0, 0); PG8_STAGE(PG8_SA(1, 1), a1 + hstepA, voffA);
            PG8_WAIT_V(8); PG8_WAIT_L(0); PG8_BAR; PG8_MMA(0, 0, At, B0); PG8_MMA(0, 1, At, B1); PG8_BAR; PG8_SCHED;
            PG8_LDA(At, 0, 1); PG8_STAGE(PG8_SB(0, 0), b2, voffB); PG8_STAGE(PG8_SB(0, 1), b2 + hstepB, voffB); PG8_STAGE(PG8_SA(0, 0), a2, voffA);
            PG8_WAIT_V(8); PG8_WAIT_L(0); PG8_BAR; PG8_MMA(1, 0, At, B0); PG8_MMA(1, 1, At, B1); PG8_BAR; PG8_SCHED;
            PG8_LDB(B0, 1, 0); PG8_LDB(B1, 1, 1); PG8_SCHED; PG8_LDA(At, 1, 0); PG8_STAGE(PG8_SA(0, 1), a2 + hstepA, voffA);
            PG8_WAIT_V(8); PG8_WAIT_L(0); PG8_BAR; PG8_MMA(0, 0, At, B0); PG8_MMA(0, 1, At, B1); PG8_BAR; PG8_SCHED;
            PG8_LDA(At, 1, 1); PG8_STAGE(PG8_SB(1, 0), b3, voffB); PG8_STAGE(PG8_SB(1, 1), b3 + hstepB, voffB); PG8_STAGE(PG8_SA(1, 0), a3, voffA);
            PG8_WAIT_V(8); PG8_WAIT_L(0); PG8_BAR; PG8_MMA(1, 0, At, B0); PG8_MMA(1, 1, At, B1); PG8_BAR; PG8_SCHED;
        }
        if (wr == 0) PG8_BAR;
        PG8_SCHED; E(acc, cur, wr, wc, fr, fq); PG8_SCHED;
        if (!has_next) break;
#pragma unroll
        for (int a = 0; a < 2; ++a)
#pragma unroll
            for (int b = 0; b < 2; ++b)
#pragma unroll
                for (int m = 0; m < 4; ++m)
#pragma unroll
                    for (int n = 0; n < 2; ++n) acc[a][b][m][n] = (f32x4){0.f, 0.f, 0.f, 0.f};
        cur = nxt; cA = nA; cB = nB; ++ui;
        if (wr == 1) PG8_BAR;
    }
    PG8_WAIT_V(0);
    PG8_BAR;
#undef PG8_SA
#undef PG8_SB
#undef PG8_STAGE
#undef PG8_LDA
#undef PG8_LDB
#undef PG8_MMA
#undef PG8_WAIT_V
#undef PG8_WAIT_L
#undef PG8_BAR
#undef PG8_SCHED
#undef PG8_APTR
#undef PG8_BPTR
}

typedef const f32x4 (&AccRef)[2][2][4][2];

struct EpiSwiglu {
    static constexpr bool PERM = true;
    bf16_t* O;
    __device__ __forceinline__ void operator()(AccRef acc, const Unit& u, int wr, int wc, int fr, int fq) const {
        const int kt = u.pn * 2 + (wc >> 1); const int ob = fr * 64 + 16 * fq; const int inblk = ((wc & 1) * 1024) + (ob ^ (((ob >> 9) & 1) << 5));
#pragma unroll
        for (int ai = 0; ai < 2; ++ai)
#pragma unroll
            for (int m = 0; m < 4; ++m) {
                bf16_t* rowp = (bf16_t*)((char*)O + ((size_t)(u.pm * 2 + ai) * (FF / 64) + kt) * 16384 + (wr * 4 + m) * 2048 + inblk);
                const f32x4 g0 = acc[ai][0][m][0], g1 = acc[ai][0][m][1], u0 = acc[ai][1][m][0], u1 = acc[ai][1][m][1];
#define SWI2(G, U, a) ({ const f32x2 g_ = (f32x2){G[a], G[a + 1]}, u_ = (f32x2){U[a], U[a + 1]}; const f32x2 t_ = g_ * (-LOG2E); \
                    f32x2 d_; d_.x = __builtin_amdgcn_exp2f(t_.x); d_.y = __builtin_amdgcn_exp2f(t_.y); d_ = d_ + 1.0f; \
                    f32x2 r_; r_.x = __builtin_amdgcn_rcpf(d_.x); r_.y = __builtin_amdgcn_rcpf(d_.y); const f32x2 v_ = (g_ * u_) * r_; cvt_pk_bf16(v_.x, v_.y); })
                u32x4 w; w.x = SWI2(g0, u0, 0); w.y = SWI2(g0, u0, 2); w.z = SWI2(g1, u1, 0); w.w = SWI2(g1, u1, 2);
#undef SWI2
                *(u32x4*)rowp = w;
            }
    }
};
struct EpiResid {
    static constexpr bool PERM = false;
    const float* base0; const float* base1; float* out; float scale;
    __device__ __forceinline__ void operator()(AccRef acc, const Unit& u, int wr, int wc, int fr, int fq) const {
        const int rt = u.pm * BM; const float* bs = rt < TP ? base0 + (size_t)rt * DM : base1 + (size_t)(rt - TP) * DM; float* op = out + (size_t)rt * DM;
        const int col0 = u.pn * BM + wc * 32 + 4 * fq;
#pragma unroll
        for (int ai = 0; ai < 2; ++ai)
#pragma unroll
            for (int m = 0; m < 4; ++m) { const size_t off = (size_t)(ai * HALF + wr * 64 + m * 16 + fr) * DM + col0;
#pragma unroll
                for (int bj = 0; bj < 2; ++bj)
#pragma unroll
                    for (int n = 0; n < 2; ++n) { const f32x4 b = *(const f32x4*)(bs + off + bj * HALF + n * 16); *(f32x4*)(op + off + bj * HALF + n * 16) = b + acc[ai][bj][m][n] * scale; }
                if (m == 3) asm volatile("" ::: "memory"); }
    }
};
template <bool BF> struct EpiResidBf {
    static constexpr bool PERM = true;
    const float* base0; const float* base1; const bf16_t* baseb; bf16_t* xb; float scale;
    __device__ __forceinline__ void operator()(AccRef acc, const Unit& u, int wr, int wc, int fr, int fq) const {
        const int rt = u.pm * BM; const int col0 = u.pn * BM + wc * 32 + 8 * fq;
        const float* bs = rt < TP ? base0 : base1 - (size_t)TP * DM;
#pragma unroll
        for (int ai = 0; ai < 2; ++ai)
#pragma unroll
            for (int m = 0; m < 4; ++m) { const size_t off = (size_t)(rt + ai * HALF + wr * 64 + m * 16 + fr) * DM + col0;
#pragma unroll
                for (int bj = 0; bj < 2; ++bj) { f32x4 b0, b1;
                    if (BF) { const u32x4 w = *(const u32x4*)(baseb + off + bj * HALF); b0 = (f32x4){bf_lo(w.x), bf_hi(w.x), bf_lo(w.y), bf_hi(w.y)}; b1 = (f32x4){bf_lo(w.z), bf_hi(w.z), bf_lo(w.w), bf_hi(w.w)}; }
                    else { b0 = *(const f32x4*)(bs + off + bj * HALF); b1 = *(const f32x4*)(bs + off + bj * HALF + 4); }
                    const f32x4 v0 = b0 + acc[ai][bj][m][0] * scale, v1 = b1 + acc[ai][bj][m][1] * scale;
                    u32x4 w; w.x = cvt_pk_bf16(v0[0], v0[1]); w.y = cvt_pk_bf16(v0[2], v0[3]); w.z = cvt_pk_bf16(v1[0], v1[1]); w.w = cvt_pk_bf16(v1[2], v1[3]);
                    *(u32x4*)(xb + off + bj * HALF) = w; }
                if (m == 3) asm volatile("" ::: "memory"); }
    }
};
struct EpiResidX0 {
    static constexpr bool PERM = true;
    const bf16_t* xn; const float* irs; const float* ig; bf16_t* xb;
    __device__ __forceinline__ void operator()(AccRef acc, const Unit& u, int wr, int wc, int fr, int fq) const {
        const int rt = u.pm * BM; const int col0 = u.pn * BM + wc * 32 + 8 * fq;
        f32x4 g0[2], g1[2];
#pragma unroll
        for (int bj = 0; bj < 2; ++bj) { g0[bj] = *(const f32x4*)(ig + col0 + bj * HALF); g1[bj] = *(const f32x4*)(ig + col0 + bj * HALF + 4); }
#pragma unroll
        for (int ai = 0; ai < 2; ++ai)
#pragma unroll
            for (int m = 0; m < 4; ++m) { const int row = rt + ai * HALF + wr * 64 + m * 16 + fr; const size_t off = (size_t)row * DM + col0; const float rs = irs[row];
#pragma unroll
                for (int bj = 0; bj < 2; ++bj) { const u32x4 w = *(const u32x4*)(xn + off + bj * HALF);
                    const f32x4 b0 = (f32x4){bf_lo(w.x), bf_hi(w.x), bf_lo(w.y), bf_hi(w.y)} * g0[bj] * rs, b1 = (f32x4){bf_lo(w.z), bf_hi(w.z), bf_lo(w.w), bf_hi(w.w)} * g1[bj] * rs;
                    const f32x4 v0 = b0 + acc[ai][bj][m][0] * 0.5f, v1 = b1 + acc[ai][bj][m][1] * 0.5f;
                    u32x4 o; o.x = cvt_pk_bf16(v0[0], v0[1]); o.y = cvt_pk_bf16(v0[2], v0[3]); o.z = cvt_pk_bf16(v1[0], v1[1]); o.w = cvt_pk_bf16(v1[2], v1[3]);
                    *(u32x4*)(xb + off + bj * HALF) = o; }
                if (m == 3) asm volatile("" ::: "memory"); }
    }
};
struct EpiWin {
    static constexpr bool PERM = true;
    bf16_t *xrg, *grg, *qc, *kvc, *kr; float* ssq; const f32x2* rope;
    __device__ __forceinline__ void operator()(AccRef acc, const Unit& u, int wr, int wc, int fr, int fq) const {
        const int row0 = u.pm * BM + wr * 64 + fr; const int pn = u.pn;
        if (pn < 11) {
            bf16_t* dst; int ld, cb;
            if (pn < 4) { dst = xrg; ld = RG; cb = 256 * pn; } else if (pn < 8) { dst = grg; ld = RG; cb = 256 * (pn - 4); } else if (pn < 10) { dst = qc; ld = QL; cb = 256 * (pn - 8); } else { dst = kvc; ld = KVL; cb = 0; }
            const int col0 = cb + wc * 32 + 8 * fq;
#pragma unroll
            for (int ai = 0; ai < 2; ++ai)
#pragma unroll
                for (int m = 0; m < 4; ++m) { const int row = row0 + ai * HALF + m * 16; float s = 0.f;
#pragma unroll
                    for (int bj = 0; bj < 2; ++bj) { const f32x4 v0 = acc[ai][bj][m][0], v1 = acc[ai][bj][m][1];
                        s += (v0[0] * v0[0] + v0[1] * v0[1]) + (v0[2] * v0[2] + v0[3] * v0[3]) + (v1[0] * v1[0] + v1[1] * v1[1]) + (v1[2] * v1[2] + v1[3] * v1[3]);
                        u32x4 w; w.x = cvt_pk_bf16(v0[0], v0[1]); w.y = cvt_pk_bf16(v0[2], v0[3]); w.z = cvt_pk_bf16(v1[0], v1[1]); w.w = cvt_pk_bf16(v1[2], v1[3]);
                        *(u32x4*)(dst + (size_t)row * ld + col0 + bj * HALF) = w; }
                    if (pn >= 8) { s += __shfl_xor(s, 16); s += __shfl_xor(s, 32); if (fq == 0) ssq[(size_t)row * 12 + (pn - 8) * 4 + wc] = s; }
                }
        } else if (wc == 0) {
#pragma unroll
            for (int ai = 0; ai < 2; ++ai)
#pragma unroll
                for (int m = 0; m < 4; ++m) { const int row = row0 + ai * HALF + m * 16; const int pos = row_pos(row);
                    const f32x2* rp = rope + (size_t)pos * 32 + 8 * fq; float o1[8], o2[8];
#pragma unroll
                    for (int n = 0; n < 2; ++n)
#pragma unroll
                        for (int j = 0; j < 4; ++j) { const f32x2 cs = rp[4 * n + j]; const float x1 = acc[ai][0][m][n][j], x2 = acc[ai][1][m][n][j]; o1[4 * n + j] = x1 * cs.x - x2 * cs.y; o2[4 * n + j] = x2 * cs.x + x1 * cs.y; }
                    u32x4 w1, w2; w1.x = cvt_pk_bf16(o1[0], o1[1]); w1.y = cvt_pk_bf16(o1[2], o1[3]); w1.z = cvt_pk_bf16(o1[4], o1[5]); w1.w = cvt_pk_bf16(o1[6], o1[7]);
                    w2.x = cvt_pk_bf16(o2[0], o2[1]); w2.y = cvt_pk_bf16(o2[2], o2[3]); w2.z = cvt_pk_bf16(o2[4], o2[5]); w2.w = cvt_pk_bf16(o2[6], o2[7]);
                    *(u32x4*)(kr + (size_t)row * 64 + 8 * fq) = w1; *(u32x4*)(kr + (size_t)row * 64 + 32 + 8 * fq) = w2; }
        }
    }
};
struct EpiQ {
    static constexpr bool PERM = true;
    bf16_t* Q; const float* ssq; const f32x2* rope;
    __device__ __forceinline__ void operator()(AccRef acc, const Unit& u, int wr, int wc, int fr, int fq) const {
        const int row0 = u.pm * BM + wr * 64 + fr; const int pn = u.pn;
#pragma unroll
        for (int ai = 0; ai < 2; ++ai)
#pragma unroll
            for (int m = 0; m < 4; ++m) { const int row = row0 + ai * HALF + m * 16;
                const f32x4 sa = *(const f32x4*)(ssq + (size_t)row * 12), sb = *(const f32x4*)(ssq + (size_t)row * 12 + 4);
                const float rstd = __builtin_amdgcn_rsqf(((sa[0] + sa[1]) + (sa[2] + sa[3]) + (sb[0] + sb[1]) + (sb[2] + sb[3])) * (1.0f / QL) + EPS);
                bf16_t* qrow = Q + (size_t)row * NQ;
                if (pn < 4) {
#pragma unroll
                    for (int bj = 0; bj < 2; ++bj) { const f32x4 v0 = acc[ai][bj][m][0] * rstd, v1 = acc[ai][bj][m][1] * rstd;
                        u32x4 w; w.x = cvt_pk_bf16(v0[0], v0[1]); w.y = cvt_pk_bf16(v0[2], v0[3]); w.z = cvt_pk_bf16(v1[0], v1[1]); w.w = cvt_pk_bf16(v1[2], v1[3]);
                        *(u32x4*)(qrow + (2 * pn + bj) * 192 + wc * 32 + 8 * fq) = w; }
                } else {
                    const int h = 4 * (pn - 4) + wc; const int pos = row_pos(row); const f32x2* rp = rope + (size_t)pos * 32 + 8 * fq; float o1[8], o2[8];
#pragma unroll
                    for (int n = 0; n < 2; ++n)
#pragma unroll
                        for (int j = 0; j < 4; ++j) { const f32x2 cs = rp[4 * n + j]; const float x1 = acc[ai][0][m][n][j] * rstd, x2 = acc[ai][1][m][n][j] * rstd; o1[4 * n + j] = x1 * cs.x - x2 * cs.y; o2[4 * n + j] = x2 * cs.x + x1 * cs.y; }
                    u32x4 w1, w2; w1.x = cvt_pk_bf16(o1[0], o1[1]); w1.y = cvt_pk_bf16(o1[2], o1[3]); w1.z = cvt_pk_bf16(o1[4], o1[5]); w1.w = cvt_pk_bf16(o1[6], o1[7]);
                    w2.x = cvt_pk_bf16(o2[0], o2[1]); w2.y = cvt_pk_bf16(o2[2], o2[3]); w2.z = cvt_pk_bf16(o2[4], o2[5]); w2.w = cvt_pk_bf16(o2[6], o2[7]);
                    *(u32x4*)(qrow + h * 192 + 128 + 8 * fq) = w1; *(u32x4*)(qrow + h * 192 + 160 + 8 * fq) = w2;
                }
            }
    }
};
struct EpiKV {
    static constexpr bool PERM = true;
    bf16_t* KV; const float* ssq;
    __device__ __forceinline__ void operator()(AccRef acc, const Unit& u, int wr, int wc, int fr, int fq) const {
        const int row0 = u.pm * BM + wr * 64 + fr; const int col0 = u.pn * BM + wc * 32 + 8 * fq;
#pragma unroll
        for (int ai = 0; ai < 2; ++ai)
#pragma unroll
            for (int m = 0; m < 4; ++m) { const int row = row0 + ai * HALF + m * 16;
                const f32x4 sa = *(const f32x4*)(ssq + (size_t)row * 12 + 8);
                const float rstd = __builtin_amdgcn_rsqf(((sa[0] + sa[1]) + (sa[2] + sa[3])) * (1.0f / KVL) + EPS);
#pragma unroll
                for (int bj = 0; bj < 2; ++bj) { const f32x4 v0 = acc[ai][bj][m][0] * rstd, v1 = acc[ai][bj][m][1] * rstd;
                    u32x4 w; w.x = cvt_pk_bf16(v0[0], v0[1]); w.y = cvt_pk_bf16(v0[2], v0[3]); w.z = cvt_pk_bf16(v1[0], v1[1]); w.w = cvt_pk_bf16(v1[2], v1[3]);
                    *(u32x4*)(KV + (size_t)row * NKV + col0 + bj * HALF) = w; }
            }
    }
};
struct EpiGates {
    static constexpr bool PERM = true;
    const bf16_t* xc; _Float16 *laf, *bf, *lab, *bb; const float *b_a, *b_x, *cst;
    __device__ __forceinline__ void operator()(AccRef acc, const Unit& u, int wr, int wc, int fr, int fq) const {
        const int dir = u.pn >> 3, cg_ = u.pn & 7; const int c0 = cg_ * 128 + wc * 32 + 8 * fq; const int row0 = u.pm * BM + wr * 64 + fr;
        char* LA = (char*)(dir ? lab : laf); char* BBp = (char*)(dir ? bb : bf); const char* xcp = (const char*)xc;
        const unsigned off0 = (unsigned)(row0 * RG + c0) * 2u;
#pragma unroll
        for (int n = 0; n < 2; ++n) {
            const f32x4 ba = *(const f32x4*)(b_a + dir * RG + c0 + 4 * n), bx = *(const f32x4*)(b_x + dir * RG + c0 + 4 * n), cs = *(const f32x4*)(cst + dir * RG + c0 + 4 * n);
#pragma unroll
            for (int ai = 0; ai < 2; ++ai)
#pragma unroll
                for (int m = 0; m < 4; ++m) { const unsigned off = off0 + (unsigned)(((ai * HALF + m * 16) * RG + 4 * n) * 2);
                    const u32x2 xw = *(const u32x2*)(xcp + off);
                    h16x2 la0, la1, bo0, bo1;
#pragma unroll
                    for (int j = 0; j < 4; ++j) { const unsigned w = xw[j >> 1]; const float xv = (j & 1) ? bf_hi(w) : bf_lo(w);
                        const float r = sigmoidf_(acc[ai][0][m][n][j] + ba[j]), ig = sigmoidf_(acc[ai][1][m][n][j] + bx[j]);
                        const float l2 = r * cs[j];
                        const float x = 2.0f * l2 * 0.6931471805599453f;
                        const float om = (x > -0.02f) ? -x * (1.0f + x * (0.5f + x * (1.0f / 6.0f))) : 1.0f - __builtin_amdgcn_exp2f(2.0f * l2);
                        const _Float16 lh = (_Float16)l2, bh = (_Float16)(__builtin_amdgcn_sqrtf(om) * ig * xv);
                        if (j < 2) { la0[j] = lh; bo0[j] = bh; } else { la1[j - 2] = lh; bo1[j - 2] = bh; } }
                    u32x2 lw, bw; lw.x = __builtin_bit_cast(unsigned, la0); lw.y = __builtin_bit_cast(unsigned, la1); bw.x = __builtin_bit_cast(unsigned, bo0); bw.y = __builtin_bit_cast(unsigned, bo1);
                    *(u32x2*)(LA + off) = lw; *(u32x2*)(BBp + off) = bw;
                    asm volatile("" ::: "memory");
                }
        }
    }
};
}

namespace att {
constexpr int KSLOT = 64 * 192 * 2, VSLOT = 64 * 128 * 2;
constexpr int LDS_K = 0, LDS_V = 2 * KSLOT, LDS_WS = LDS_V + 3 * VSLOT, LDS_TOT = LDS_WS + 8 * 64 * 4;
constexpr float SCALE = 0.07216878364870322f;
constexpr float THR = 8.f;
#define SBAR() __builtin_amdgcn_sched_barrier(0)
__device__ __forceinline__ int crow(int r, int hi) { return (r & 3) + 8 * (r >> 2) + 4 * hi; }

__device__ __forceinline__ void partialSM(f32x16& p0, f32x16& p1, float& m_reg, float& alpha) {
    constexpr float C = SCALE * LOG2E;
    float pmax = p0[0];
#pragma unroll
    for (int r = 1; r < 16; ++r) pmax = fmaxf(pmax, p0[r]);
#pragma unroll
    for (int r = 0; r < 16; ++r) pmax = fmaxf(pmax, p1[r]);
    { auto rr = __builtin_amdgcn_permlane32_swap(__float_as_uint(pmax), __float_as_uint(pmax), false, false); pmax = fmaxf(__uint_as_float(rr[0]), __uint_as_float(rr[1])); }
    float mn;
    if (__builtin_expect(__all(pmax - m_reg <= THR / SCALE), 1)) { mn = m_reg; alpha = 1.f; }
    else { mn = fmaxf(m_reg, pmax); alpha = __builtin_amdgcn_exp2f((m_reg - mn) * C); m_reg = mn; }
    const float mnC = -mn * C;
#pragma unroll
    for (int r = 0; r < 16; ++r) p0[r] = fmaf(p0[r], C, mnC);
#pragma unroll
    for (int r = 0; r < 16; ++r) p1[r] = fmaf(p1[r], C, mnC);
#pragma unroll
    for (int r = 0; r < 16; ++r) p0[r] = __builtin_amdgcn_exp2f(p0[r]);
}
__device__ __forceinline__ void finishSM(f32x16& p0, f32x16& p1, float alpha, float& l_reg, bf16x8& pa0, bf16x8& pa1, bf16x8& pa2, bf16x8& pa3) {
#pragma unroll
    for (int r = 0; r < 16; ++r) p1[r] = __builtin_amdgcn_exp2f(p1[r]);
    float ps = 0;
#pragma unroll
    for (int r = 0; r < 16; ++r) ps += p0[r];
#pragma unroll
    for (int r = 0; r < 16; ++r) ps += p1[r];
    { auto rr = __builtin_amdgcn_permlane32_swap(__float_as_uint(ps), __float_as_uint(ps), false, false); ps = __uint_as_float(rr[0]) + __uint_as_float(rr[1]); }
    l_reg = l_reg * alpha + ps;
#define PK4(P, BASE, OUT) do { unsigned a0 = cvt_pk_bf16(P[BASE + 0], P[BASE + 1]), a1 = cvt_pk_bf16(P[BASE + 2], P[BASE + 3]);   \
    unsigned b0 = cvt_pk_bf16(P[BASE + 4], P[BASE + 5]), b1 = cvt_pk_bf16(P[BASE + 6], P[BASE + 7]);                              \
    auto r0 = __builtin_amdgcn_permlane32_swap(a0, b0, false, false); auto r1 = __builtin_amdgcn_permlane32_swap(a1, b1, false, false); \
    u32x4 w = {r0[0], r1[0], r0[1], r1[1]}; OUT = __builtin_bit_cast(bf16x8, w); } while (0)
    PK4(p0, 0, pa0); PK4(p0, 8, pa1); PK4(p1, 0, pa2); PK4(p1, 8, pa3);
#undef PK4
}
__device__ __forceinline__ void qkt(f32x16& p0, f32x16& p1, const LAS unsigned char* Ks, const bf16x8 (&qr)[12], int r32, int hi) {
    p0 = f32x16{}; p1 = f32x16{};
    const int sw = (r32 & 7) << 4;
#pragma unroll
    for (int d0 = 0; d0 < 12; ++d0) { const int cb = (d0 * 16 + hi * 8) * 2;
        const bf16x8 b0 = *(const LAS bf16x8*)(Ks + r32 * 384 + (cb ^ sw));
        const bf16x8 b1 = *(const LAS bf16x8*)(Ks + (32 + r32) * 384 + (cb ^ sw));
        p0 = __builtin_amdgcn_mfma_f32_32x32x16_bf16(b0, qr[d0], p0, 0, 0, 0);
        p1 = __builtin_amdgcn_mfma_f32_32x32x16_bf16(b1, qr[d0], p1, 0, 0, 0); }
}
__device__ __forceinline__ int v_rd_base(int lane) { return ((lane & 3) << 3) | (((lane >> 2) & 3) << 6) | (((lane >> 4) & 1) << 5) | (((lane >> 5) & 1) << 8); }
constexpr int v_rd_off(int d0, int ks, int half) { return d0 * 512 + ks * 4096 + half * 2048; }
template <int OFF> __device__ __forceinline__ s16x4 tr_read(int vb) { s16x4 r; asm volatile("ds_read_b64_tr_b16 %0, %1 offset:%2" : "=&v"(r) : "v"(vb), "i"(OFF) : "memory"); return r; }
template <int KS> __device__ __forceinline__ void pv_ks(f32x16 (&o)[4], int vb, bf16x8 pa) {
    const s16x4 l0 = tr_read<v_rd_off(0, KS, 0)>(vb), h0 = tr_read<v_rd_off(0, KS, 1)>(vb), l1 = tr_read<v_rd_off(1, KS, 0)>(vb), h1 = tr_read<v_rd_off(1, KS, 1)>(vb);
    const s16x4 l2 = tr_read<v_rd_off(2, KS, 0)>(vb), h2 = tr_read<v_rd_off(2, KS, 1)>(vb), l3 = tr_read<v_rd_off(3, KS, 0)>(vb), h3 = tr_read<v_rd_off(3, KS, 1)>(vb);
    asm volatile("s_waitcnt lgkmcnt(0)" ::: "memory"); SBAR();
#define PK(L, H) (bf16x8){L[0], L[1], L[2], L[3], H[0], H[1], H[2], H[3]}
    o[0] = __builtin_amdgcn_mfma_f32_32x32x16_bf16(pa, PK(l0, h0), o[0], 0, 0, 0);
    o[1] = __builtin_amdgcn_mfma_f32_32x32x16_bf16(pa, PK(l1, h1), o[1], 0, 0, 0);
    o[2] = __builtin_amdgcn_mfma_f32_32x32x16_bf16(pa, PK(l2, h2), o[2], 0, 0, 0);
    o[3] = __builtin_amdgcn_mfma_f32_32x32x16_bf16(pa, PK(l3, h3), o[3], 0, 0, 0);
#undef PK
}
__device__ __forceinline__ void pv_d0(f32x16 (&o)[4], int vb, bf16x8 pa0, bf16x8 pa1, bf16x8 pa2, bf16x8 pa3) {
    pv_ks<0>(o, vb, pa0); pv_ks<1>(o, vb, pa1); pv_ks<2>(o, vb, pa2); pv_ks<3>(o, vb, pa3);
}

__device__ __forceinline__ void attn_unit(LAS unsigned char* lds, const bf16_t* __restrict__ Q, const bf16_t* __restrict__ KV, const bf16_t* __restrict__ KR, bf16_t* __restrict__ O,
                                          int qrow0, int krow0, int seq, int h) {
    const int tid = threadIdx.x, lane = tid & 63, r32 = lane & 31, hi = lane >> 5; const int wid = __builtin_amdgcn_readfirstlane(tid >> 6);
    LAS float* wsf = (LAS float*)(lds + LDS_WS) + wid * 64; LAS float* li_l = wsf; LAS float* al_l = wsf + 32;
    const char* base = (const char*)KV;
    const int krdiff = (int)((const char*)KR - (const char*)KV);
    int ksrc[3]; int kstep[3];
#pragma unroll
    for (int i = 0; i < 3; ++i) { const int p = (i * 8 + wid) * 64 + lane; const int row = p / 24, slot = p % 24, ck = slot ^ (row & 7);
        if (ck < 16) { ksrc[i] = ((krow0 + row) * NKV + h * 256 + ck * 8) * 2; kstep[i] = 64 * NKV * 2; }
        else { ksrc[i] = krdiff + ((krow0 + row) * 64 + (ck - 16) * 8) * 2; kstep[i] = 64 * 64 * 2; } }
    int vsrc[2];
#pragma unroll
    for (int i = 0; i < 2; ++i) { const int j = (i * 8 + wid) * 64 + lane; const int s = j >> 5, kk = (s >> 2) * 8 + ((j >> 2) & 7), c = (s & 3) * 32 + (j & 3) * 8;
        const int k = (kk & ~0xC) | ((kk & 4) << 1) | ((kk & 8) >> 1);
        vsrc[i] = ((krow0 + k) * NKV + h * 256 + 128 + c) * 2; }
#define DMA_K(t, ks) do { _Pragma("unroll") for (int _i = 0; _i < 3; ++_i) \
        __builtin_amdgcn_global_load_lds((const unsigned*)(base + (ksrc[_i] + (t) * kstep[_i])), (LAS unsigned*)(lds + LDS_K + (ks) * KSLOT + (_i * 8 + wid) * 1024), 16, 0, 0); } while (0)
#define DMA_V(t, voff) do { _Pragma("unroll") for (int _i = 0; _i < 2; ++_i) \
        __builtin_amdgcn_global_load_lds((const unsigned*)(base + (vsrc[_i] + (t) * (64 * NKV * 2))), (LAS unsigned*)(lds + LDS_V + (voff) + (_i * 8 + wid) * 1024), 16, 0, 0); } while (0)
#define SYNC_ALL() do { asm volatile("s_waitcnt vmcnt(0) lgkmcnt(0)" ::: "memory"); __syncthreads(); } while (0)
#define RESC(a) do { if (__any((a) < 1.f)) { if (hi == 0) al_l[r32] = (a); asm volatile("s_waitcnt lgkmcnt(0)" ::: "memory"); \
        _Pragma("unroll") for (int d = 0; d < 4; ++d) _Pragma("unroll") for (int r = 0; r < 16; ++r) o[d][r] *= al_l[crow(r, hi)]; } } while (0)
    const int NT = seq / 64;
    DMA_K(0, 0); DMA_V(0, 0);
    bf16x8 qr[12];
    { const bf16_t* Qw = Q + (size_t)(qrow0 + wid * 32 + r32) * NQ + h * 192 + hi * 8;
#pragma unroll
      for (int d0 = 0; d0 < 12; ++d0) qr[d0] = *(const bf16x8*)(Qw + d0 * 16); }
    float m_reg = -1e30f, l_reg = 0.f; f32x16 o[4];
#pragma unroll
    for (int d = 0; d < 4; ++d) o[d] = f32x16{};
    const int vb0 = (int)(uintptr_t)(lds + LDS_V) + v_rd_base(lane);
    f32x16 pA0, pA1, pB0, pB1; float alA, alB; bf16x8 pa0, pa1, pa2, pa3;
    SYNC_ALL();
    DMA_K(1, 1); DMA_V(1, VSLOT);
    qkt(pA0, pA1, lds + LDS_K, qr, r32, hi); partialSM(pA0, pA1, m_reg, alA);
    int vs_prev = 0, vs_cur = VSLOT, vs_next = 2 * VSLOT;
#define ROT() do { const int _t = vs_prev; vs_prev = vs_cur; vs_cur = vs_next; vs_next = _t; } while (0)
    for (int j = 1; j + 1 < NT; j += 2) {
        SYNC_ALL();
        DMA_K(j + 1, 0); DMA_V(j + 1, vs_next);
        SBAR(); qkt(pB0, pB1, lds + LDS_K + KSLOT, qr, r32, hi);
        finishSM(pA0, pA1, alA, l_reg, pa0, pa1, pa2, pa3); SBAR();
        pv_d0(o, vb0 + vs_prev, pa0, pa1, pa2, pa3); partialSM(pB0, pB1, m_reg, alB);
        RESC(alB); ROT();
        SYNC_ALL();
        if (j + 2 < NT) { DMA_K(j + 2, 1); DMA_V(j + 2, vs_next); }
        SBAR(); qkt(pA0, pA1, lds + LDS_K, qr, r32, hi);
        finishSM(pB0, pB1, alB, l_reg, pa0, pa1, pa2, pa3); SBAR();
        pv_d0(o, vb0 + vs_prev, pa0, pa1, pa2, pa3); partialSM(pA0, pA1, m_reg, alA);
        RESC(alA); ROT();
    }
    SYNC_ALL();
    SBAR(); qkt(pB0, pB1, lds + LDS_K + KSLOT, qr, r32, hi);
    finishSM(pA0, pA1, alA, l_reg, pa0, pa1, pa2, pa3); SBAR();
    pv_d0(o, vb0 + vs_prev, pa0, pa1, pa2, pa3); partialSM(pB0, pB1, m_reg, alB);
    RESC(alB);
    finishSM(pB0, pB1, alB, l_reg, pa0, pa1, pa2, pa3); SBAR();
    pv_d0(o, vb0 + vs_cur, pa0, pa1, pa2, pa3);
    if (hi == 0) li_l[r32] = l_reg; asm volatile("s_waitcnt lgkmcnt(0)" ::: "memory");
    float rli[16];
#pragma unroll
    for (int r = 0; r < 16; ++r) rli[r] = __builtin_amdgcn_rcpf(li_l[crow(r, hi)]);
    bf16_t* Ow = O + (size_t)(qrow0 + wid * 32) * RG + h * 128;
#pragma unroll
    for (int r = 0; r < 16; ++r) { const int orow = crow(r, hi);
#pragma unroll
        for (int d0 = 0; d0 < 4; ++d0) Ow[(size_t)orow * RG + d0 * 32 + r32] = (bf16_t)(cvt_pk_bf16(o[d0][r] * rli[r], 0.f) & 0xffffu); }
    SYNC_ALL();
#undef DMA_K
#undef DMA_V
#undef SYNC_ALL
#undef RESC
#undef ROT
}
#undef SBAR
}


#define XB_TMO      128
#define XB_XCNT(j)  (256  + 64 * (j))
#define XB_XSUB(j)  (1280 + 64 * (j))
#define XB_XGEN(j)  (2304 + 64 * (j))
#define XB_TOP      3328
#define XB_TOPGEN   3392
#define XCD_BAR_WORDS 3456
#define XB_SPIN_CAP (1u << 18)
__device__ __forceinline__ unsigned xb_ld(unsigned* p)              { return __hip_atomic_load(p, __ATOMIC_RELAXED, __HIP_MEMORY_SCOPE_AGENT); }
__device__ __forceinline__ unsigned xb_add(unsigned* p, unsigned v) { return __hip_atomic_fetch_add(p, v, __ATOMIC_RELAXED, __HIP_MEMORY_SCOPE_AGENT); }
__device__ __forceinline__ unsigned xb_xcc_id() { return (unsigned)__builtin_amdgcn_s_getreg((3 << 11) | 20) & 0xFu; }
#define XB_SPIN(cond, bar) do { unsigned _sp = 0; while (cond) { \
    if ((++_sp & 255u) == 0u) { if (xb_ld(&(bar)[XB_TMO])) break; if (_sp > XB_SPIN_CAP) { atomicAdd(&(bar)[XB_TMO], 1u); break; } } } } while (0)
__device__ __forceinline__ void xcd_barrier_post(unsigned* bar) { if (threadIdx.x == 0) (void)xb_add(&bar[XB_XCNT(xb_xcc_id())], 1u); }
__device__ __forceinline__ void xcd_barrier_complete(unsigned* bar, unsigned x, unsigned& nloc, unsigned& nx) {
    const unsigned G = gridDim.x * gridDim.y * gridDim.z;
    unsigned sum, cnt, mine, sp = 0u;
    for (;;) {
        sum = 0u; cnt = 0u; mine = 0u;
#pragma unroll
        for (unsigned j = 0; j < 16; ++j) { const unsigned c = xb_ld(&bar[XB_XCNT(j)]); sum += c; cnt += (c > 0u) ? 1u : 0u; mine = (j == x) ? c : mine; }
        if (sum == G) break;
        __builtin_amdgcn_s_sleep(1);
        if ((++sp & 255u) == 0u) { if (xb_ld(&bar[XB_TMO])) break; if (sp > XB_SPIN_CAP) { atomicAdd(&bar[XB_TMO], 1u); break; } }
    }
    nloc = mine > 0u ? mine : 1u; nx = cnt > 0u ? cnt : 1u;
}
__device__ __forceinline__ void xcd_barrier(unsigned* bar, volatile LAS unsigned* st) {
    asm volatile("s_waitcnt vmcnt(0)" ::: "memory");
    __syncthreads();
    if (threadIdx.x == 0) {
        const unsigned x = xb_xcc_id();
        __builtin_amdgcn_s_waitcnt(0);
        unsigned nloc = st[0], nx = st[1];
        if (nloc == 0u) { xcd_barrier_complete(bar, x, nloc, nx); st[0] = nloc; st[1] = nx; }
        const unsigned old = xb_add(&bar[XB_XSUB(x)], 1u);
        const unsigned gen = old / nloc;
        if (old + 1u == (gen + 1u) * nloc) {
            __builtin_amdgcn_fence(__ATOMIC_RELEASE, "agent");
            asm volatile("s_waitcnt vmcnt(0)" ::: "memory");
            const unsigned og = xb_add(&bar[XB_TOP], 1u);
            const unsigned tg = og / nx;
            if (og + 1u == (tg + 1u) * nx) xb_add(&bar[XB_TOPGEN], 1u);
            else XB_SPIN(xb_ld(&bar[XB_TOPGEN]) == tg, bar);
            __builtin_amdgcn_fence(__ATOMIC_ACQUIRE, "agent");
            xb_add(&bar[XB_XGEN(x)], 1u);
            asm volatile("s_waitcnt vmcnt(0)" ::: "memory");
        } else {
            XB_SPIN(xb_ld(&bar[XB_XGEN(x)]) == gen, bar);
            __builtin_amdgcn_fence(__ATOMIC_ACQUIRE, "agent");
            asm volatile("s_waitcnt vmcnt(0)" ::: "memory");
        }
    }
    __syncthreads();
}
struct MapId { __device__ __forceinline__ int operator()(int n) const { return n; } };
struct MapGU { int off; __device__ __forceinline__ int operator()(int n) const { return (n >> 7) * 256 + off + (n & 127); } };
struct MapWin { __device__ __forceinline__ int operator()(int n) const { if (n < 2816) return n; const int i = n - 2816; return 2816 + (i < 32 ? i : 128 + (i - 32)); } };
struct MapQ { __device__ __forceinline__ int operator()(int n) const { const int h = n / 192, d = n - h * 192; if (d < 128) return h * 128 + d; const int i = d - 128;
    return 1024 + (h >> 2) * 256 + (h & 3) * 32 + (i & 31) + ((i >> 5) << 7); } };

template <class MapN>
__device__ __forceinline__ void transpose_item(const float* __restrict__ W, int N, const float* __restrict__ kscale, bf16_t* __restrict__ WT, int ldt, MapN mapn, LAS float* scr, int item, int lane) {
    const int nblk = N / 32, kb = item / nblk, nb = item - kb * nblk, k0 = 64 * kb, n0 = 32 * nb;
#pragma unroll 8
    for (int i = 0; i < 32; ++i) { const int kk = 2 * i + (lane >> 5); float v = W[(size_t)(k0 + kk) * N + n0 + (lane & 31)]; if (kscale) v *= kscale[k0 + kk]; scr[kk * 33 + (lane & 31)] = v; }
    asm volatile("s_waitcnt lgkmcnt(0)" ::: "memory");
    const int c = lane & 7;
#pragma unroll
    for (int j = 0; j < 4; ++j) { const int n = (lane >> 3) + 8 * j; const LAS float* s = scr + (8 * c) * 33 + n;
        u32x4 o; o.x = cvt_pk_bf16(s[0 * 33], s[1 * 33]); o.y = cvt_pk_bf16(s[2 * 33], s[3 * 33]); o.z = cvt_pk_bf16(s[4 * 33], s[5 * 33]); o.w = cvt_pk_bf16(s[6 * 33], s[7 * 33]);
        *(u32x4*)(WT + (size_t)mapn(n0 + n) * ldt + k0 + 8 * c) = o; }
    asm volatile("s_waitcnt lgkmcnt(0)" ::: "memory");
}
__device__ __forceinline__ void rms_row_to_bf16(const float* __restrict__ xrow, const float* __restrict__ g, bf16_t* __restrict__ orow, int lane, float* irs_out = nullptr) {
    const f32x4* xr = (const f32x4*)xrow + lane; const f32x4* gr = (const f32x4*)g + lane;
    f32x4 v[8]; float s = 0.f;
#pragma unroll
    for (int j = 0; j < 8; ++j) { v[j] = xr[64 * j]; s += (v[j].x * v[j].x + v[j].y * v[j].y) + (v[j].z * v[j].z + v[j].w * v[j].w); }
    const float ms = wave_sum(s) * (1.f / DM) + EPS; const float rstd = __builtin_amdgcn_rsqf(ms);
    if (irs_out && lane == 0) *irs_out = __builtin_amdgcn_sqrtf(ms);
    u32x2* o8 = (u32x2*)orow + lane;
#pragma unroll
    for (int j = 0; j < 8; ++j) { const f32x4 gg = gr[64 * j]; u32x2 w; w.x = cvt_pk_bf16(v[j].x * rstd * gg.x, v[j].y * rstd * gg.y); w.y = cvt_pk_bf16(v[j].z * rstd * gg.z, v[j].w * rstd * gg.w); o8[64 * j] = w; }
}
__device__ __forceinline__ void rms_rowbf_to_bf16(const bf16_t* __restrict__ xrow, const float* __restrict__ g, bf16_t* __restrict__ orow, int lane) {
    const u32x4* xr = (const u32x4*)xrow + lane; float v[4][8]; float s = 0.f;
#pragma unroll
    for (int j = 0; j < 4; ++j) { const u32x4 w = xr[64 * j];
#pragma unroll
        for (int q = 0; q < 4; ++q) { v[j][2 * q] = bf_lo(w[q]); v[j][2 * q + 1] = bf_hi(w[q]); s += v[j][2 * q] * v[j][2 * q] + v[j][2 * q + 1] * v[j][2 * q + 1]; } }
    const float rstd = __builtin_amdgcn_rsqf(wave_sum(s) * (1.f / DM) + EPS);
#pragma unroll
    for (int j = 0; j < 4; ++j) { const int c = 8 * (lane + 64 * j); const f32x4 g0 = *(const f32x4*)(g + c), g1 = *(const f32x4*)(g + c + 4); u32x4 w;
        w.x = cvt_pk_bf16(v[j][0] * rstd * g0[0], v[j][1] * rstd * g0[1]); w.y = cvt_pk_bf16(v[j][2] * rstd * g0[2], v[j][3] * rstd * g0[3]);
        w.z = cvt_pk_bf16(v[j][4] * rstd * g1[0], v[j][5] * rstd * g1[1]); w.w = cvt_pk_bf16(v[j][6] * rstd * g1[2], v[j][7] * rstd * g1[3]);
        *(u32x4*)(orow + c) = w; }
}
__device__ __forceinline__ float gelu_tanh(float x) { const float u2 = 2.0f * 0.7978845608028654f * (x + 0.044715f * x * x * x); return x * __builtin_amdgcn_rcpf(1.0f + __builtin_amdgcn_exp2f(-u2 * LOG2E)); }


#ifdef MK_DEBUG
__device__ __forceinline__ float bfv(const bf16_t* p) { return __uint_as_float((unsigned)(*p) << 16); }
__device__ __forceinline__ void dbg_flag(int* dbg, int k, float got, float ref) { if (!(fabsf(got - ref) <= 0.03f + 0.03f * fabsf(ref))) atomicAdd(dbg + k, 1); }
#define DBG_SAMPLE_ROW(tid) (((tid) * 97 + 13) % T)
#endif
struct Args { const float* in[27]; float* out; unsigned char* ws; int ph_lo, ph_hi; };
constexpr int NPH = 18;

__global__ void __launch_bounds__(512, 2) mega(Args args) {
    extern __shared__ __attribute__((aligned(16))) unsigned char lds_raw[];
    LAS unsigned char* lds = (LAS unsigned char*)lds_raw;
    cg::grid_group grid = cg::this_grid();
    const int tid = threadIdx.x, lane = tid & 63, wave = __builtin_amdgcn_readfirstlane(tid >> 6);
    const int G = gridDim.x, bx = blockIdx.x; const int vcu = (G % 8 == 0) ? (bx % 8) * (G / 8) + bx / 8 : bx;
    const int gw = vcu * 8 + wave, NGW = G * 8;
    const long gt = (long)vcu * 512 + tid, NGT = (long)G * 512;
    unsigned char* ws = args.ws;
    const float* xp = args.in[0]; const float* xs = args.in[1];
    float* out = args.out;
#define Win_t ((bf16_t*)(ws + WS_WIN))
#define Wq_t ((bf16_t*)(ws + WS_WQ))
#define Wkv_t ((bf16_t*)(ws + WS_WKV))
#define Wgate_t ((bf16_t*)(ws + WS_WGATE))
#define Wout_t ((bf16_t*)(ws + WS_WOUT))
#define Wgu_t ((bf16_t*)(ws + WS_WGU))
#define Wd_t ((bf16_t*)(ws + WS_WD))
#define ROPE ((f32x2*)(ws + WS_ROPE))
#define CST ((float*)(ws + WS_CST))
#define SSQ ((float*)(ws + WS_SSQ))
#define CP ((float*)(ws + WS_CP))
#define CHH ((float*)(ws + WS_CHH))
#define CIN ((float*)(ws + WS_CIN))
#define XN ((bf16_t*)(ws + WS_XN))
#define LAF ((_Float16*)(ws + WS_XN))
#define BF ((_Float16*)(ws + WS_XN + HALFROW))
#define ACT ((bf16_t*)(ws + WS_ACT))
#define IRS ((float*)(ws + WS_IRS))
#define IG ((float*)(ws + WS_IG))
#define X1B ((bf16_t*)out)
#define X2B ((bf16_t*)out + (size_t)T * DM)
#define GRG ((bf16_t*)(ws + WS_GRG))
#define YATT GRG
#define QC ((bf16_t*)(ws + WS_QC))
#define KVC ((bf16_t*)(ws + WS_KVC))
#define KR ((bf16_t*)(ws + WS_KR))
#define XRG ((bf16_t*)(ws + WS_XRG))
#define YRG XRG
#define XC ((bf16_t*)(ws + WS_XC))
#define LAB ((_Float16*)(ws + WS_LAB))
#define BB ((_Float16*)(ws + WS_BB))
#define QB ((bf16_t*)(ws + WS_Q))
#define KVB ((bf16_t*)(ws + WS_KV))
    LAS float* scr = (LAS float*)(lds + wave * 16384);

    { volatile LAS unsigned* MISC = (volatile LAS unsigned*)(lds + 131072 + 320); if (tid < 32) MISC[tid] = 0u; }
    __syncthreads();
    xcd_barrier_post((unsigned*)(ws + WS_BAR));
    const int lo = args.ph_lo, hi = args.ph_hi;
#ifndef PH_MASK
#define PH_MASK 0x3ffff
#endif
#define IN(k) (((PH_MASK >> (k)) & 1) && lo <= (k) && (k) < hi)
#ifndef REP_MASK
#define REP_MASK 0
#endif
#ifndef DUP_MASK
#define DUP_MASK 0
#endif
#define DUPK(k) ((((DUP_MASK) >> (k)) & 1) ? 2 : 1)
#define REPS(k) ((((REP_MASK) >> (k)) & 1) ? 2 : 1)
#define SEAM(k) do { if (IN(k) && IN((k) + 1)) { if (hi < 0) grid.sync(); xcd_barrier((unsigned*)(ws + WS_BAR), (volatile LAS unsigned*)(lds + 131072 + 320) + 8); } } while (0)
#ifdef MK_DEBUG
    int* DBG = (int*)(ws + WS_DBG); float* DSAV = (float*)(ws + WS_DBG + 64);
#endif

    if (IN(0)) for (int rep_ = 0; rep_ < REPS(0); ++rep_) {
        constexpr int I_G = 32 * 176, I_D = 88 * 64, I_IN = 32 * 90, I_Q = 8 * 48, I_KV = 4 * 64, I_O = 32 * 64;
        constexpr int NIT = 2 * I_G + I_D + I_IN + I_Q + I_KV + I_O;
        for (int it = gw; it < NIT; it += NGW) {
            int r = it;
            if (r < I_G) { transpose_item(args.in[3], FF, nullptr, Wgu_t, DM, MapGU{0}, scr, r, lane); continue; } r -= I_G;
            if (r < I_G) { transpose_item(args.in[4], FF, nullptr, Wgu_t, DM, MapGU{128}, scr, r, lane); continue; } r -= I_G;
            if (r < I_D) { transpose_item(args.in[5], DM, nullptr, Wd_t, FF, MapId{}, scr, r, lane); continue; } r -= I_D;
            if (r < I_IN) { transpose_item(args.in[7], 2880, nullptr, Win_t, DM, MapWin{}, scr, r, lane); continue; } r -= I_IN;
            if (r < I_Q) { transpose_item(args.in[16], NQ, args.in[15], Wq_t, QL, MapQ{}, scr, r, lane); continue; } r -= I_Q;
            if (r < I_KV) { transpose_item(args.in[18], NKV, args.in[17], Wkv_t, KVL, MapId{}, scr, r, lane); continue; } r -= I_KV;
            transpose_item(args.in[21], DM, nullptr, Wout_t, DM, MapId{}, scr, r, lane);
        }
        for (long e = gt; e < 4096 * 16; e += NGT) { const int row = (int)(e >> 4), k8 = (int)(e & 15) * 8;
            const int dir = row >> 11, cgi = (row >> 8) & 7, gate = (row >> 7) & 1, cl = row & 127; const int c = cgi * 128 + cl, hb = c >> 6, j = c & 63;
            const float* w = (gate ? args.in[12] : args.in[10]) + ((size_t)(dir * 16 + hb) * 64) * 64;
            float v[8];
#pragma unroll
            for (int q = 0; q < 8; ++q) { const int ci = cgi * 128 + k8 + q; v[q] = ((ci >> 6) == hb) ? w[(ci & 63) * 64 + j] : 0.f; }
            u32x4 o; o.x = cvt_pk_bf16(v[0], v[1]); o.y = cvt_pk_bf16(v[2], v[3]); o.z = cvt_pk_bf16(v[4], v[5]); o.w = cvt_pk_bf16(v[6], v[7]);
            *(u32x4*)(Wgate_t + (size_t)row * 128 + k8) = o; }
#ifdef MK_DEBUG
        if (bx == 0 && tid < 16) DBG[tid] = 0;
#endif
        for (long e = gt; e < 2 * RG; e += NGT) { const float lam = args.in[14][e]; const float sp = (lam < -20.f) ? -lam : log1pf(expf(-lam)); CST[e] = -8.0f * sp * LOG2E; }
        for (long e = gt; e < 8192 * 32; e += NGT) { const int pos = (int)(e >> 5), i = (int)(e & 31);
            const float inv = 1.0f / powf(10000.0f, (float)(2 * i) / 64.0f);
            const float ang = (float)pos * inv;
            const double rev = (double)ang * 0.15915494309189535; const float fr = (float)(rev - rint(rev));
            ROPE[e] = (f32x2){__builtin_amdgcn_cosf(fr), __builtin_amdgcn_sinf(fr)}; }
        for (int m = gw; m < T; m += NGW) rms_row_to_bf16(m < TP ? xp + (size_t)m * DM : xs + (size_t)(m - TP) * DM, args.in[2], XN + (size_t)m * DM, lane, IRS + m);
        for (long e = gt; e < DM; e += NGT) IG[e] = 1.0f / args.in[2][e];
    }
    SEAM(0);
    if (IN(1)) for (int rep_ = 0; rep_ < REPS(1); ++rep_) { pg8::Gemm g{XN, Wgu_t, DM, DM, DM, T / 256, NGU / 256, 1, 0, 0}; pg8::StaticOrder S; S.init(g.nM, g.nN, G, bx, DUPK(1)); pg8::EpiSwiglu E{ACT}; pg8::gemm_phase(lds, g, S, E); }
    SEAM(1);
    if (IN(2)) for (int rep_ = 0; rep_ < REPS(2); ++rep_) { pg8::Gemm g{ACT, Wd_t, FF, FF, FF, T / 256, DM / 256, 1, 0, 1}; pg8::StaticOrder S; S.init(g.nM, g.nN, G, bx, DUPK(2), 4); pg8::EpiResidX0 E{XN, IRS, IG, X1B}; pg8::gemm_phase(lds, g, S, E); }
    SEAM(2);
    if (IN(3)) for (int rep_ = 0; rep_ < REPS(3); ++rep_) {
        constexpr int I_G = 32 * 176, I_D = 88 * 64, NIT = 2 * I_G + I_D;
        for (int it = gw; it < NIT; it += NGW) {
            int r = it;
            if (r < I_G) { transpose_item(args.in[23], FF, nullptr, Wgu_t, DM, MapGU{0}, scr, r, lane); continue; } r -= I_G;
            if (r < I_G) { transpose_item(args.in[24], FF, nullptr, Wgu_t, DM, MapGU{128}, scr, r, lane); continue; } r -= I_G;
            transpose_item(args.in[25], DM, nullptr, Wd_t, FF, MapId{}, scr, r, lane);
        }
        for (int m = gw; m < T; m += NGW) rms_rowbf_to_bf16(X1B + (size_t)m * DM, args.in[6], XN + (size_t)m * DM, lane);
    }
    SEAM(3);
    if (IN(4)) for (int rep_ = 0; rep_ < REPS(4); ++rep_) { pg8::Gemm g{XN, Win_t, DM, DM, DM, T / 256, DINP / 256, 1, 0, 0}; pg8::StaticOrder S; S.init(g.nM, g.nN, G, bx, DUPK(4)); pg8::EpiWin E{XRG, GRG, QC, KVC, KR, SSQ, ROPE}; pg8::gemm_phase(lds, g, S, E); }
    SEAM(4);
    if (IN(5)) for (int rep_ = 0; rep_ < REPS(5); ++rep_) {
        const float* cw = args.in[8]; const float* cb = args.in[9];
        for (long e = gt; e < (long)T * 128; e += NGT) { const int row = (int)(e >> 7), c0 = (int)(e & 127) * 8; const int pos = row_pos(row), S = row < TP ? 2048 : 8192;
            float a[8];
#pragma unroll
            for (int q = 0; q < 8; ++q) a[q] = cb[c0 + q];
#pragma unroll
            for (int k = 0; k < 4; ++k) { const int p = pos - 2 + k; if (p >= 0 && p < S) { const u32x4 xw = *(const u32x4*)(XRG + (size_t)(row - 2 + k) * RG + c0);
#pragma unroll
                    for (int q = 0; q < 8; ++q) { const unsigned w = xw[q >> 1]; a[q] += cw[k * RG + c0 + q] * ((q & 1) ? bf_hi(w) : bf_lo(w)); } } }
            u32x4 o; o.x = cvt_pk_bf16(a[0], a[1]); o.y = cvt_pk_bf16(a[2], a[3]); o.z = cvt_pk_bf16(a[4], a[5]); o.w = cvt_pk_bf16(a[6], a[7]);
            *(u32x4*)(XC + (size_t)row * RG + c0) = o; }
    }
    SEAM(5);
    if (IN(6)) for (int rep_ = 0; rep_ < REPS(6); ++rep_) { int k128 = 128; asm volatile("" : "+s"(k128)); pg8::Gemm g{XC, Wgate_t, RG, 128, k128, T / 256, 16, 8, 128, 0}; pg8::StaticOrder S; S.init(g.nM, g.nN, G, bx, DUPK(6)); pg8::EpiGates E{XC, LAF, BF, LAB, BB, args.in[11], args.in[13], CST}; pg8::gemm_phase(lds, g, S, E); }
    SEAM(6);
    if (IN(7)) for (int rep_ = 0; rep_ < REPS(7); ++rep_) {
        for (long e = gt; e < (long)2 * NCHUNK * 256; e += NGT) { const int c0 = (int)(e & 255) * 4; const int ch = (int)((e >> 8) % NCHUNK), dir = (int)((e >> 8) / NCHUNK);
            const _Float16* LA = dir ? LAB : LAF; const _Float16* B = dir ? BB : BF;
            float P0 = 1.f, P1 = 1.f, P2 = 1.f, P3 = 1.f, H0 = 0.f, H1 = 0.f, H2 = 0.f, H3 = 0.f;
            const int t0 = ch * CH_L + (dir ? CH_L - 1 : 0); const long tstep = dir ? -(long)RG : (long)RG;
            const _Float16* pl = LA + (size_t)t0 * RG + c0; const _Float16* pb = B + (size_t)t0 * RG + c0;
#pragma unroll 1
            for (int s8 = 0; s8 < CH_L; s8 += 8) {
                h16x4 lv[8], bv[8];
#pragma unroll
                for (int q = 0; q < 8; ++q) { lv[q] = *(const h16x4*)(pl + q * tstep); bv[q] = *(const h16x4*)(pb + q * tstep); }
                pl += 8 * tstep; pb += 8 * tstep;
#pragma unroll
                for (int q = 0; q < 8; ++q) {
                    const float a0 = __builtin_amdgcn_exp2f((float)lv[q][0]), a1 = __builtin_amdgcn_exp2f((float)lv[q][1]), a2 = __builtin_amdgcn_exp2f((float)lv[q][2]), a3 = __builtin_amdgcn_exp2f((float)lv[q][3]);
                    H0 = a0 * H0 + (float)bv[q][0]; H1 = a1 * H1 + (float)bv[q][1]; H2 = a2 * H2 + (float)bv[q][2]; H3 = a3 * H3 + (float)bv[q][3];
                    P0 *= a0; P1 *= a1; P2 *= a2; P3 *= a3; } }
            const size_t o = ((size_t)dir * NCHUNK + ch) * RG + c0;
            *(f32x4*)(CP + o) = (f32x4){P0, P1, P2, P3}; *(f32x4*)(CHH + o) = (f32x4){H0, H1, H2, H3}; }
    }
    SEAM(7);
    if (IN(8)) for (int rep_ = 0; rep_ < REPS(8); ++rep_) {
        for (long e = gt; e < (long)9 * 2 * RG; e += NGT) { const int c = (int)(e & (RG - 1)); const int dir = (int)((e >> 10) & 1), sq = (int)(e >> 11);
            const int ch0 = sq < 8 ? sq * 64 : 512, nch = sq < 8 ? 64 : 256;
            float hcar = 0.f;
#pragma unroll 8
            for (int s = 0; s < nch; ++s) { const int ch = ch0 + (dir ? (nch - 1 - s) : s); const size_t o = ((size_t)dir * NCHUNK + ch) * RG + c;
                CIN[o] = hcar; hcar = CP[o] * hcar + CHH[o]; }
        }
    }
    SEAM(8);
    if (IN(9)) for (int rep_ = 0; rep_ < REPS(9); ++rep_) {
        for (long e = gt; e < (long)NCHUNK * 512; e += NGT) { const int c0 = (int)(e & 511) * 2; const int ch = (int)(e >> 9);
            float hf[CH_L][2];
            const char* pLAF = (const char*)LAF; const char* pBF = (const char*)BF; const char* pLAB = (const char*)LAB; const char* pBB = (const char*)BB; const char* pG = (const char*)GRG; char* pY = (char*)YRG;
            unsigned off = (unsigned)((ch * CH_L) * RG + c0) * 2u;
            { float h0 = CIN[(size_t)ch * RG + c0], h1 = CIN[(size_t)ch * RG + c0 + 1];
#pragma unroll
              for (int s = 0; s < CH_L; ++s) {
                  const h16x2 l = __builtin_bit_cast(h16x2, *(const unsigned*)(pLAF + off)), b = __builtin_bit_cast(h16x2, *(const unsigned*)(pBF + off));
                  h0 = __builtin_amdgcn_exp2f((float)l[0]) * h0 + (float)b[0]; h1 = __builtin_amdgcn_exp2f((float)l[1]) * h1 + (float)b[1]; hf[s][0] = h0; hf[s][1] = h1;
                  if (s + 1 < CH_L) { off += RG * 2; asm volatile("" : "+v"(off)); } } }
            { float h0 = CIN[((size_t)NCHUNK + ch) * RG + c0], h1 = CIN[((size_t)NCHUNK + ch) * RG + c0 + 1];
#pragma unroll
              for (int s = CH_L - 1; s >= 0; --s) {
                  const h16x2 l = __builtin_bit_cast(h16x2, *(const unsigned*)(pLAB + off)), b = __builtin_bit_cast(h16x2, *(const unsigned*)(pBB + off));
                  h0 = __builtin_amdgcn_exp2f((float)l[0]) * h0 + (float)b[0]; h1 = __builtin_amdgcn_exp2f((float)l[1]) * h1 + (float)b[1];
                  const unsigned gwd = *(const unsigned*)(pG + off);
                  const float y0 = (hf[s][0] + h0) * gelu_tanh(bf_lo(gwd)), y1 = (hf[s][1] + h1) * gelu_tanh(bf_hi(gwd));
                  *(unsigned*)(pY + off) = cvt_pk_bf16(y0, y1);
                  if (s > 0) { off -= RG * 2; asm volatile("" : "+v"(off)); } } }
        }
    }
    SEAM(9);
    if (IN(10)) for (int rep_ = 0; rep_ < REPS(10); ++rep_) {
        { pg8::Gemm g{QC, Wq_t, QL, QL, QL, T / 256, NQ / 256, 1, 0, 0}; pg8::StaticOrder S; S.init(g.nM, g.nN, G, bx, DUPK(10)); pg8::EpiQ E{QB, SSQ, ROPE}; pg8::gemm_phase(lds, g, S, E); }
        { pg8::Gemm g{KVC, Wkv_t, KVL, KVL, KVL, T / 256, NKV / 256, 1, 0, 0}; pg8::StaticOrder S; S.init(g.nM, g.nN, G, bx, DUPK(10)); pg8::EpiKV E{KVB, SSQ}; pg8::gemm_phase(lds, g, S, E); }
    }
    SEAM(10);
    if (IN(11)) for (int rep_ = 0; rep_ < REPS(11); ++rep_) {
        for (int u = vcu; u < 256; u += G) att::attn_unit(lds, QB, KVB, KR, YATT, TP + (u & 31) * 256, TP, 8192, u >> 5);
        for (int p = vcu; p < 256; p += G)
            for (int k = 0; k < 2; ++k) { const int u = 2 * p + k; const int sh = u >> 3, qb = u & 7, sq = sh >> 3, h = sh & 7;
                att::attn_unit(lds, QB, KVB, KR, YATT, sq * 2048 + qb * 256, sq * 2048, 2048, h); }
    }
    SEAM(11);
    if (IN(12)) for (int rep_ = 0; rep_ < REPS(12); ++rep_) {
        const float* g1 = args.in[19]; const float* g2 = args.in[20];
        for (int m = gw; m < T; m += NGW) {
#pragma unroll
            for (int half = 0; half < 2; ++half) { const bf16_t* src = (half ? YATT : YRG) + (size_t)m * RG + lane * 16; const float* gg = (half ? g2 : g1) + lane * 16;
                const u32x4 w0 = *(const u32x4*)src, w1 = *(const u32x4*)(src + 8); float v[16];
#pragma unroll
                for (int q = 0; q < 4; ++q) { v[2 * q] = bf_lo(w0[q]); v[2 * q + 1] = bf_hi(w0[q]); v[8 + 2 * q] = bf_lo(w1[q]); v[8 + 2 * q + 1] = bf_hi(w1[q]); }
                float s = 0.f;
#pragma unroll
                for (int q = 0; q < 16; ++q) s += v[q] * v[q];
                const float rstd = __builtin_amdgcn_rsqf(wave_sum(s) * (1.f / RG) + EPS);
                u32x4 o0, o1;
#pragma unroll
                for (int q = 0; q < 4; ++q) { o0[q] = cvt_pk_bf16(v[2 * q] * rstd * gg[2 * q], v[2 * q + 1] * rstd * gg[2 * q + 1]); o1[q] = cvt_pk_bf16(v[8 + 2 * q] * rstd * gg[8 + 2 * q], v[8 + 2 * q + 1] * rstd * gg[8 + 2 * q + 1]); }
                bf16_t* dst = XN + (size_t)m * DM + half * RG + lane * 16; *(u32x4*)dst = o0; *(u32x4*)(dst + 8) = o1; }
        }
    }
    SEAM(12);
    if (IN(13)) for (int rep_ = 0; rep_ < REPS(13); ++rep_) { pg8::Gemm g{XN, Wout_t, DM, DM, DM, T / 256, DM / 256, 1, 0, 0}; pg8::StaticOrder S; S.init(g.nM, g.nN, G, bx, DUPK(13), 4); pg8::EpiResidBf<true> E{nullptr, nullptr, X1B, X2B, 1.0f}; pg8::gemm_phase(lds, g, S, E); }
    SEAM(13);
    if (IN(14)) for (int rep_ = 0; rep_ < REPS(14); ++rep_) { for (int m = gw; m < T; m += NGW) rms_rowbf_to_bf16(X2B + (size_t)m * DM, args.in[22], XN + (size_t)m * DM, lane); }
    SEAM(14);
    if (IN(15)) for (int rep_ = 0; rep_ < REPS(15); ++rep_) { pg8::Gemm g{XN, Wgu_t, DM, DM, DM, T / 256, NGU / 256, 1, 0, 0}; pg8::StaticOrder S; S.init(g.nM, g.nN, G, bx, DUPK(15)); pg8::EpiSwiglu E{ACT}; pg8::gemm_phase(lds, g, S, E); }
    SEAM(15);
    if (IN(16)) for (int rep_ = 0; rep_ < REPS(16); ++rep_) { pg8::Gemm g{ACT, Wd_t, FF, FF, FF, T / 256, DM / 256, 1, 0, 1}; pg8::StaticOrder S; S.init(g.nM, g.nN, G, bx, DUPK(16), 4); pg8::EpiResidBf<true> E{nullptr, nullptr, X2B, XN, 0.5f}; pg8::gemm_phase(lds, g, S, E); }
    SEAM(16);
    if (IN(17)) for (int rep_ = 0; rep_ < REPS(17); ++rep_) {
        const float* g = args.in[26];
        float dscale = 1.f;
#ifdef MK_DEBUG
        { int kf = 0; for (int k = 15; k >= 1; --k) if (DBG[k] > 0) kf = k; dscale = 1.f + 0.5f * kf; }
#endif
        for (int m = gw; m < T; m += NGW) { const u32x4* xr = (const u32x4*)(XN + (size_t)m * DM) + lane;
            float v[4][8]; float s = 0.f;
#pragma unroll
            for (int j = 0; j < 4; ++j) { const u32x4 w = xr[64 * j];
#pragma unroll
                for (int q = 0; q < 4; ++q) { v[j][2 * q] = bf_lo(w[q]); v[j][2 * q + 1] = bf_hi(w[q]); s += v[j][2 * q] * v[j][2 * q] + v[j][2 * q + 1] * v[j][2 * q + 1]; } }
            const float rstd = __builtin_amdgcn_rsqf(wave_sum(s) * (1.f / DM) + EPS) * dscale;
            float* orow = out + (size_t)m * DM;
#pragma unroll
            for (int j = 0; j < 4; ++j) { const int c = 8 * (lane + 64 * j); const f32x4 g0 = *(const f32x4*)(g + c), g1 = *(const f32x4*)(g + c + 4);
                *(f32x4*)(orow + c) = (f32x4){v[j][0] * rstd * g0[0], v[j][1] * rstd * g0[1], v[j][2] * rstd * g0[2], v[j][3] * rstd * g0[3]};
                *(f32x4*)(orow + c + 4) = (f32x4){v[j][4] * rstd * g1[0], v[j][5] * rstd * g1[1], v[j][6] * rstd * g1[2], v[j][7] * rstd * g1[3]}; } }
    }
#undef IN
#undef SEAM
}

#ifdef MK_DEBUG
__global__ void __launch_bounds__(512) dbg_check(Args args, int seam) {
    unsigned char* ws = args.ws; const float* xp = args.in[0]; const float* xs = args.in[1]; float* out = args.out; const int tid = threadIdx.x;
    int* DBG = (int*)(ws + WS_DBG); float* DSAV = (float*)(ws + WS_DBG + 64); const int row = DBG_SAMPLE_ROW(tid);
    if (seam == 1) { const int f = (tid * 53 + 7) % FF; float g = 0.f, u = 0.f; for (int k = 0; k < DM; ++k) { const float a = bfv(XN + (size_t)row * DM + k); g += a * args.in[3][(size_t)k * FF + f]; u += a * args.in[4][(size_t)k * FF + f]; }
        dbg_flag(DBG, 1, bfv(ACT + (size_t)row * FF + f), g * sigmoidf_(g) * u); }
    if (seam == 2) { const int c = (tid * 29 + 3) % DM; float a = 0.f; for (int f = 0; f < FF; ++f) a += bfv(ACT + (size_t)row * FF + f) * args.in[5][(size_t)f * DM + c];
        const float xv = row < TP ? xp[(size_t)row * DM + c] : xs[(size_t)(row - TP) * DM + c]; dbg_flag(DBG, 2, out[(size_t)row * DM + c], xv + 0.5f * a); }
    if (seam == 4) { const int n = (tid * 37 + 5) % 2880;
        if (n < 2816) { float z = 0.f; for (int k = 0; k < DM; ++k) z += bfv(XN + (size_t)row * DM + k) * args.in[7][(size_t)k * 2880 + n];
            const float got = n < 1024 ? bfv(XRG + (size_t)row * RG + n) : n < 2048 ? bfv(GRG + (size_t)row * RG + n - 1024) : n < 2560 ? bfv(QC + (size_t)row * QL + n - 2048) : bfv(KVC + (size_t)row * KVL + n - 2560);
            dbg_flag(DBG, 3, got, z); }
        else { const int i = (n - 2816) & 31; float x1 = 0.f, x2 = 0.f; for (int k = 0; k < DM; ++k) { const float a = bfv(XN + (size_t)row * DM + k); x1 += a * args.in[7][(size_t)k * 2880 + 2816 + i]; x2 += a * args.in[7][(size_t)k * 2880 + 2848 + i]; }
            const float ang = (float)row_pos(row) * (1.0f / powf(10000.0f, (float)(2 * i) / 64.0f)); const float c = cosf(ang), sn = sinf(ang);
            dbg_flag(DBG, 4, bfv(KR + (size_t)row * 64 + i), x1 * c - x2 * sn); dbg_flag(DBG, 4, bfv(KR + (size_t)row * 64 + 32 + i), x2 * c + x1 * sn); } }
    if (seam == 5) { const int c = (tid * 29 + 3) % RG; const int pos = row_pos(row), S = row < TP ? 2048 : 8192; float a = args.in[9][c];
        for (int k = 0; k < 4; ++k) { const int p = pos - 2 + k; if (p >= 0 && p < S) a += args.in[8][k * RG + c] * bfv(XRG + (size_t)(row - 2 + k) * RG + c); }
        dbg_flag(DBG, 5, bfv(XC + (size_t)row * RG + c), a); }
    if (seam == 6) { const int c = (tid * 29 + 3) % RG; const int dir = tid & 1, hb = c >> 6, j = c & 63; float pa = args.in[11][dir * RG + c], px = args.in[13][dir * RG + c];
        for (int i = 0; i < 64; ++i) { const float xv = bfv(XC + (size_t)row * RG + hb * 64 + i); pa += xv * args.in[10][((size_t)(dir * 16 + hb) * 64 + i) * 64 + j]; px += xv * args.in[12][((size_t)(dir * 16 + hb) * 64 + i) * 64 + j]; }
        const float lam = args.in[14][dir * RG + c]; const float r = 1.f / (1.f + expf(-pa)), ig = 1.f / (1.f + expf(-px)); const float loga = -8.f * r * log1pf(expf(-lam));
        const float bref = sqrtf(-expm1f(2.f * loga)) * ig * bfv(XC + (size_t)row * RG + c);
        const _Float16* LA = dir ? LAB : LAF; const _Float16* Bp = dir ? BB : BF;
        if (!(fabsf((float)LA[(size_t)row * RG + c] - loga * LOG2E) <= 1e-4f + 0.02f * fabsf(loga * LOG2E))) atomicAdd(DBG + 6, 1);
        if (!(fabsf((float)Bp[(size_t)row * RG + c] - bref) <= 2e-3f + 0.03f * fabsf(bref))) atomicAdd(DBG + 7, 1); }
    if (seam == 9) { { const int c = (tid * 29 + 3) % RG; const int dir = tid & 1; const int ch = (tid * 7 + 1) % NCHUNK; const _Float16* LA = dir ? LAB : LAF; const _Float16* Bp = dir ? BB : BF;
            float P = 1.f, H = 0.f; for (int s2 = 0; s2 < CH_L; ++s2) { const int t = ch * CH_L + (dir ? CH_L - 1 - s2 : s2); const float a = exp2f((float)LA[(size_t)t * RG + c]); H = a * H + (float)Bp[(size_t)t * RG + c]; P *= a; }
            const size_t o = ((size_t)dir * NCHUNK + ch) * RG + c;
            if (!(fabsf(CP[o] - P) <= 1e-3f + 0.01f * fabsf(P))) atomicAdd(DBG + 1, 1);
            if (!(fabsf(CHH[o] - H) <= 1e-3f + 0.01f * fabsf(H))) atomicAdd(DBG + 2, 1);
            const int ch0 = ch < 512 ? (ch & ~63) : 512, nch = ch < 512 ? 64 : 256; float hc = 0.f;
            if (dir == 0) { for (int q = ch0; q < ch; ++q) { const size_t oo = ((size_t)0 * NCHUNK + q) * RG + c; hc = CP[oo] * hc + CHH[oo]; } }
            else { for (int q = ch0 + nch - 1; q > ch; --q) { const size_t oo = ((size_t)1 * NCHUNK + q) * RG + c; hc = CP[oo] * hc + CHH[oo]; } }
            if (!(fabsf(CIN[o] - hc) <= 1e-3f + 0.01f * fabsf(hc))) atomicAdd(DBG + 3, 1); }
 const int c = (tid * 29 + 3) % RG; const int s0 = row < TP ? (row & ~2047) : TP, S = row < TP ? 2048 : 8192; float hf = 0.f, hb = 0.f;
        for (int t = s0; t <= row; ++t) hf = exp2f((float)LAF[(size_t)t * RG + c]) * hf + (float)BF[(size_t)t * RG + c];
        for (int t = s0 + S - 1; t >= row; --t) hb = exp2f((float)LAB[(size_t)t * RG + c]) * hb + (float)BB[(size_t)t * RG + c];
        const float g = bfv(GRG + (size_t)row * RG + c); const float ge = 0.5f * g * (1.f + tanhf(0.7978845608f * (g + 0.044715f * g * g * g)));
        dbg_flag(DBG, 8, bfv(YRG + (size_t)row * RG + c), (hf + hb) * ge); }
    if (seam == 10) { { const int n = (tid * 37 + 5) % NQ; const int h = n / 192, d = n % 192; float ss = 0.f; for (int k = 0; k < QL; ++k) { const float a = bfv(QC + (size_t)row * QL + k); ss += a * a; }
          const float rstd = 1.f / sqrtf(ss / QL + EPS); float ref;
          if (d < 128) { float q = 0.f; for (int k = 0; k < QL; ++k) q += bfv(QC + (size_t)row * QL + k) * args.in[15][k] * args.in[16][(size_t)k * NQ + n]; ref = q * rstd; }
          else { const int i = (d - 128) & 31; float x1 = 0.f, x2 = 0.f; for (int k = 0; k < QL; ++k) { const float a = bfv(QC + (size_t)row * QL + k) * args.in[15][k]; x1 += a * args.in[16][(size_t)k * NQ + h * 192 + 128 + i]; x2 += a * args.in[16][(size_t)k * NQ + h * 192 + 160 + i]; }
            x1 *= rstd; x2 *= rstd; const float ang = (float)row_pos(row) * (1.0f / powf(10000.0f, (float)(2 * i) / 64.0f)); const float c = cosf(ang), sn = sinf(ang); ref = (d < 160) ? x1 * c - x2 * sn : x2 * c + x1 * sn; }
          dbg_flag(DBG, 9, bfv(QB + (size_t)row * NQ + n), ref); }
        { const int n = (tid * 41 + 11) % NKV; float ss = 0.f, q = 0.f; for (int k = 0; k < KVL; ++k) { const float a = bfv(KVC + (size_t)row * KVL + k); ss += a * a; q += a * args.in[17][k] * args.in[18][(size_t)k * NKV + n]; }
          dbg_flag(DBG, 10, bfv(KVB + (size_t)row * NKV + n), q / sqrtf(ss / KVL + EPS)); } }
    if (seam == 11) { const int h = tid & 7, d = (tid * 13 + 1) & 127; const int s0 = row < TP ? (row & ~2047) : TP, S = row < TP ? 2048 : 8192; float m = -1e30f, l = 0.f, o = 0.f;
        for (int t = s0; t < s0 + S; ++t) { float sc = 0.f; for (int k = 0; k < 128; ++k) sc += bfv(QB + (size_t)row * NQ + h * 192 + k) * bfv(KVB + (size_t)t * NKV + h * 256 + k);
            for (int k = 0; k < 64; ++k) sc += bfv(QB + (size_t)row * NQ + h * 192 + 128 + k) * bfv(KR + (size_t)t * 64 + k);
            sc *= 0.07216878364870322f; const float mn = fmaxf(m, sc); const float al = expf(m - mn), p = expf(sc - mn); l = l * al + p; o = o * al + p * bfv(KVB + (size_t)t * NKV + h * 256 + 128 + d); m = mn; }
        dbg_flag(DBG, 11, bfv(YATT + (size_t)row * RG + h * 128 + d), o / l); }
    if (seam == 12) { const int c = (tid * 29 + 3) % DM; const bf16_t* src = (c < RG ? YRG : YATT) + (size_t)row * RG; float ss = 0.f; for (int k = 0; k < RG; ++k) { const float a = bfv(src + k); ss += a * a; }
        dbg_flag(DBG, 12, bfv(XN + (size_t)row * DM + c), bfv(src + (c & (RG - 1))) / sqrtf(ss / RG + EPS) * (c < RG ? args.in[19][c] : args.in[20][c - RG])); DSAV[tid] = out[(size_t)row * DM + c]; }
    if (seam == 13) { const int c = (tid * 29 + 3) % DM; float a = 0.f; for (int k = 0; k < DM; ++k) a += bfv(XN + (size_t)row * DM + k) * args.in[21][(size_t)k * DM + c];
        dbg_flag(DBG, 13, out[(size_t)row * DM + c], DSAV[tid] + a); }
    if (seam == 15) { const int f = (tid * 53 + 7) % FF; float g = 0.f, u = 0.f; for (int k = 0; k < DM; ++k) { const float a = bfv(XN + (size_t)row * DM + k); g += a * args.in[23][(size_t)k * FF + f]; u += a * args.in[24][(size_t)k * FF + f]; }
        dbg_flag(DBG, 14, bfv(ACT + (size_t)row * FF + f), g * sigmoidf_(g) * u); }
}
#endif
#ifndef MK_PER_PHASE
#define MK_PER_PHASE 0
#endif
extern "C" void kernel_launch(void* const* d_in, const int* in_sizes, int n_in, void* d_out, int out_size, void* d_ws, size_t ws_size, hipStream_t stream) {
    static int grid = 0;
    if (grid == 0) {
        if (n_in != 27 || out_size != T * DM || ws_size < WS_TOP) { fprintf(stderr, "kernel_launch: unexpected shapes: n_in %d out %d ws %zu (need %zu)\n", n_in, out_size, ws_size, (size_t)WS_END); grid = -1; return; }
        int dev = 0, cus = 0, per_cu = 0;
        hipGetDevice(&dev); hipDeviceGetAttribute(&cus, hipDeviceAttributeMultiprocessorCount, dev);
        if (hipFuncSetAttribute((const void*)mega, hipFuncAttributeMaxDynamicSharedMemorySize, LDS_BYTES) != hipSuccess) { fprintf(stderr, "kernel_launch: hipFuncSetAttribute failed\n"); grid = -1; return; }
        if (hipOccupancyMaxActiveBlocksPerMultiprocessor(&per_cu, (const void*)mega, 512, LDS_BYTES) != hipSuccess || per_cu < 1) { fprintf(stderr, "kernel_launch: occupancy query says %d\n", per_cu); per_cu = 1; }
        (void)hipGetLastError();
        grid = cus * per_cu;
    }
    if (grid < 0) return;
    if (hipMemsetAsync((char*)d_ws + WS_BAR, 0, BAR_BYTES, stream) != hipSuccess) { fprintf(stderr, "kernel_launch: memset failed\n"); return; }
    Args a{};
    for (int i = 0; i < 27; ++i) a.in[i] = (const float*)d_in[i];
    a.out = (float*)d_out; a.ws = (unsigned char*)d_ws;
#if MK_PER_PHASE
    for (int p = 0; p < NPH; ++p) { a.ph_lo = p; a.ph_hi = p + 1; hipLaunchKernelGGL(mega, dim3(grid), dim3(512), LDS_BYTES, stream, a);
#ifdef MK_DEBUG
        a.ph_lo = 0; a.ph_hi = NPH; hipLaunchKernelGGL(dbg_check, dim3(1), dim3(512), 0, stream, a, p);
#endif
    }
#else
    a.ph_lo = 0; a.ph_hi = NPH;
    void* kargs[] = {&a};
    hipError_t e = hipLaunchCooperativeKernel((const void*)mega, dim3(grid), dim3(512), kargs, LDS_BYTES, stream);
    if (e != hipSuccess) fprintf(stderr, "kernel_launch: cooperative launch failed: %s (grid %d)\n", hipGetErrorString(e), grid);
#endif
}
```
